# Optimizing an MI355X kernel written in HIP

```python
import jax, jax.numpy as jnp
from jax import lax
import numpy as np

D_MODEL = 1024
BATCH = 32
SEQ = 2048
DEPTH = 1

PLE_DIM = 256
ATT_HEADS = 8
ATT_KV_HEADS = 2
HEAD_DIM = 64
ATT_WIDTH = ATT_HEADS * HEAD_DIM
KV_WIDTH = ATT_KV_HEADS * HEAD_DIM
WINDOW = 128
BLOCK_Q = 128
ROPE_THETA = 10000.0
RWKV_HEADS = 8
RWKV_HEAD = 64
RWKV_WIDTH = RWKV_HEADS * RWKV_HEAD
DECAY_LORA = 64
AAA_LORA = 64
GATE_LORA = 128
RWKV_GN_EPS = 64e-5
ATT_COLS = ATT_WIDTH + 2 * KV_WIDTH
SHIFT_COLS = 3 * RWKV_WIDTH + DECAY_LORA + AAA_LORA + GATE_LORA
GATE_COLS = 2 * D_MODEL
IN_WIDTH = ATT_COLS + SHIFT_COLS + GATE_COLS
N_GROUPS = 4
EXPERTS_PER_GROUP = 8
N_EXPERTS = N_GROUPS * EXPERTS_PER_GROUP
TOP_K = 2
D_EXPERT = 512
MOE_BLOCK = 256
NORM_EPS = 1e-6
NEG_INF = -1e30

kernel_name = "hybrid_swa_rwkv7_hiermoe_block"


def rmsnorm(x, g):
    xf = x.astype(jnp.float32)
    y = xf * lax.rsqrt(jnp.mean(xf * xf, axis=-1, keepdims=True) + NORM_EPS)
    return (y * g.astype(jnp.float32)).astype(x.dtype)


def apply_rope(t, pos):
    half = t.shape[-1] // 2
    inv_freq = ROPE_THETA ** (-jnp.arange(half, dtype=jnp.float32) / half)
    ang = pos.astype(jnp.float32)[..., None] * inv_freq
    cos = jnp.cos(ang)[:, :, None, :]
    sin = jnp.sin(ang)[:, :, None, :]
    tf = t.astype(jnp.float32)
    t1, t2 = tf[..., :half], tf[..., half:]
    return jnp.concatenate([t1 * cos - t2 * sin, t2 * cos + t1 * sin], axis=-1).astype(t.dtype)


def sliding_window_attention(q, k, v, sinks):
    B, S, H, Dh = q.shape
    nb = S // BLOCK_Q
    grp = H // ATT_KV_HEADS
    qb = q.reshape(B, nb, BLOCK_Q, ATT_KV_HEADS, grp, Dh)
    kb = k.reshape(B, nb, BLOCK_Q, ATT_KV_HEADS, Dh)
    vb = v.reshape(B, nb, BLOCK_Q, ATT_KV_HEADS, Dh)
    prev = lambda t: jnp.concatenate([jnp.zeros_like(t[:, :1]), t[:, :-1]], axis=1)
    kk = jnp.concatenate([prev(kb), kb], axis=2)
    vv = jnp.concatenate([prev(vb), vb], axis=2)
    scores = jnp.einsum('bnqkgd,bnskd->bnkgqs', qb, kk,
                        preferred_element_type=jnp.float32) * (Dh ** -0.5)
    qi = jnp.arange(BLOCK_Q)[:, None]
    si = jnp.arange(2 * BLOCK_Q)[None, :]
    diff = qi + BLOCK_Q - si
    band = (diff >= 0) & (diff < WINDOW)
    exists = (jnp.arange(nb)[:, None, None] > 0) | (si >= BLOCK_Q)[None]
    valid = band[None] & exists
    scores = jnp.where(valid[None, :, None, None], scores, NEG_INF)
    sink = sinks.astype(jnp.float32).reshape(ATT_KV_HEADS, grp)[None, None, :, :, None, None]
    m = jnp.maximum(jnp.max(scores, axis=-1, keepdims=True), sink)
    e = jnp.exp(scores - m)
    probs = e / (jnp.sum(e, axis=-1, keepdims=True) + jnp.exp(sink - m))
    out = jnp.einsum('bnkgqs,bnskd->bnqkgd', probs.astype(v.dtype), vv)
    return out.reshape(B, S, H * Dh)


def token_shift(y, mu):
    prev = jnp.pad(y, ((0, 0), (1, 0), (0, 0)))[:, :-1]
    return y + (prev - y) * mu


def rwkv7_time_mix(r, k, v, xw, xa, xg, w0, w_decay_up, a0, w_aaa_up, w_gate_up,
                   k_k, k_a, r_k, ln_x_w, ln_x_b):
    B, S, C = r.shape
    H, N = RWKV_HEADS, RWKV_HEAD
    f32 = jnp.float32
    r, k, v = r.astype(f32), k.astype(f32), v.astype(f32)
    w = -jax.nn.softplus(-(w0.astype(f32) + jnp.tanh(xw.astype(f32)) @ w_decay_up.astype(f32))) - 0.5
    decay = jnp.exp(-jnp.exp(w))
    a = jax.nn.sigmoid(a0.astype(f32) + xa.astype(f32) @ w_aaa_up.astype(f32))
    g = jax.nn.sigmoid(xg.astype(f32)) @ w_gate_up.astype(f32)
    kk = (k * k_k.astype(f32)).reshape(B, S, H, N)
    kk = kk / jnp.maximum(jnp.sqrt(jnp.sum(kk * kk, axis=-1, keepdims=True)), 1e-12)
    k = k * (1.0 + (a - 1.0) * k_a.astype(f32))

    def step(state, inp):
        r_t, w_t, k_t, v_t, kk_t, a_t = inp
        sa = jnp.einsum('bhvk,bhk->bhv', state, -kk_t)
        state = (state * w_t[:, :, None, :]
                 + sa[..., None] * (kk_t * a_t)[:, :, None, :]
                 + v_t[..., None] * k_t[:, :, None, :])
        y_t = jnp.einsum('bhvk,bhk->bhv', state, r_t)
        return state, y_t

    to_seq = lambda t: t.reshape(B, S, H, N).transpose(1, 0, 2, 3)
    xs = (to_seq(r), to_seq(decay), to_seq(k), to_seq(v), kk.transpose(1, 0, 2, 3), to_seq(a))
    _, ys = lax.scan(step, jnp.zeros((B, H, N, N), f32), xs)
    y = ys.transpose(1, 0, 2, 3)
    mu = jnp.mean(y, axis=-1, keepdims=True)
    var = jnp.mean(jnp.square(y - mu), axis=-1, keepdims=True)
    y = ((y - mu) * lax.rsqrt(var + RWKV_GN_EPS)).reshape(B, S, C)
    y = y * ln_x_w.astype(f32) + ln_x_b.astype(f32)
    bonus = jnp.sum((r * k * r_k.astype(f32)).reshape(B, S, H, N), axis=-1, keepdims=True) * v.reshape(B, S, H, N)
    y = y + bonus.reshape(B, S, C)
    return y * g


def hierarchical_moe(h, w_group, b_group, w_expert, b_expert, w_gate_e, w_up_e, w_down_e):
    B, S, D = h.shape
    T = B * S
    xt = h.reshape(T, D)
    g_prob = jax.nn.softmax((xt @ w_group + b_group).astype(jnp.float32), axis=-1)
    g_w, g_idx = lax.top_k(g_prob, 1)
    e_logits = (xt @ w_expert + b_expert).astype(jnp.float32).reshape(T, N_GROUPS, EXPERTS_PER_GROUP)
    e_sel = jnp.take_along_axis(e_logits, g_idx[:, :, None], axis=1)[:, 0]
    e_w, e_idx = lax.top_k(jax.nn.softmax(e_sel, axis=-1), TOP_K)
    e_w = e_w / jnp.sum(e_w, axis=-1, keepdims=True)
    weights = (g_w * e_w).reshape(-1)
    experts = (g_idx * EXPERTS_PER_GROUP + e_idx).reshape(-1)
    tokens = jnp.repeat(jnp.arange(T, dtype=jnp.int32), TOP_K)
    A = T * TOP_K
    order = jnp.argsort(experts)
    se, stok, sw = experts[order], tokens[order], weights[order]
    counts = jnp.bincount(experts, length=N_EXPERTS)
    starts = jnp.cumsum(counts) - counts
    padded = (counts + MOE_BLOCK - 1) // MOE_BLOCK * MOE_BLOCK
    pad_ends = jnp.cumsum(padded)
    pad_starts = pad_ends - padded
    dest = pad_starts[se] + jnp.arange(A) - starts[se]
    n_blocks = -(-A // MOE_BLOCK) + N_EXPERTS
    P = n_blocks * MOE_BLOCK
    row_tok = jnp.zeros((P,), jnp.int32).at[dest].set(stok)
    row_w = jnp.zeros((P,), jnp.float32).at[dest].set(sw.astype(jnp.float32))
    block_e = jnp.minimum(jnp.searchsorted(pad_ends, jnp.arange(n_blocks) * MOE_BLOCK, side='right'),
                          N_EXPERTS - 1)
    xrows = xt[row_tok].reshape(n_blocks, MOE_BLOCK, D)

    def expert_block(args):
        xb, e = args
        hid = jax.nn.silu(xb @ w_gate_e[e]) * (xb @ w_up_e[e])
        return hid @ w_down_e[e]

    yrows = lax.map(expert_block, (xrows, block_e)).reshape(P, D)
    out = jax.ops.segment_sum(yrows * row_w[:, None].astype(yrows.dtype), row_tok, num_segments=T)
    return out.reshape(B, S, D)


def setup_inputs(seed: int = 0) -> dict:
    key = jax.random.key(seed)
    ks = jax.random.split(key, 32)
    nrm = lambda k, shape, s: jax.random.normal(k, shape, jnp.float32) * s
    gain = lambda k, shape: 1.0 + 0.02 * jax.random.normal(k, shape, jnp.float32)
    L, D = DEPTH, D_MODEL
    offsets = jax.random.randint(ks[2], (BATCH, 1), 0, 4096, dtype=jnp.int32)
    positions = jnp.arange(SEQ, dtype=jnp.int32)[None, :] + offsets
    return {
        "x": nrm(ks[0], (BATCH, SEQ, D), 1.0),
        "p": nrm(ks[1], (DEPTH, BATCH, SEQ, PLE_DIM), 1.0),
        "positions": positions,
        "ln_mix": gain(ks[3], (L, D)),
        "w_in": nrm(ks[4], (L, D, IN_WIDTH), D ** -0.5),
        "mu_shift": jax.random.uniform(ks[5], (L, SHIFT_COLS), jnp.float32),
        "w0": jax.random.uniform(ks[6], (L, RWKV_WIDTH), jnp.float32, -6.0, 1.0),
        "w_decay_up": nrm(ks[7], (L, DECAY_LORA, RWKV_WIDTH), 0.1),
        "a0": nrm(ks[8], (L, RWKV_WIDTH), 0.1),
        "w_aaa_up": nrm(ks[9], (L, AAA_LORA, RWKV_WIDTH), 0.1),
        "w_gate_up": nrm(ks[10], (L, GATE_LORA, RWKV_WIDTH), GATE_LORA ** -0.5),
        "k_k": 0.85 + 0.05 * jax.random.normal(ks[11], (L, RWKV_WIDTH), jnp.float32),
        "k_a": 1.0 + 0.05 * jax.random.normal(ks[12], (L, RWKV_WIDTH), jnp.float32),
        "r_k": nrm(ks[13], (L, RWKV_WIDTH), 0.1),
        "ln_x_w": gain(ks[14], (L, RWKV_WIDTH)),
        "ln_x_b": nrm(ks[15], (L, RWKV_WIDTH), 0.02),
        "sinks": nrm(ks[16], (L, ATT_HEADS), 1.0),
        "w_branch_att": nrm(ks[17], (L, ATT_WIDTH, D), ATT_WIDTH ** -0.5),
        "w_branch_rwkv": nrm(ks[18], (L, RWKV_WIDTH, D), RWKV_WIDTH ** -0.5),
        "w_out": nrm(ks[19], (L, D, D), D ** -0.5),
        "ln_moe": gain(ks[20], (L, D)),
        "w_group": nrm(ks[21], (L, D, N_GROUPS), D ** -0.5),
        "b_group": nrm(ks[22], (L, N_GROUPS), 0.01),
        "w_expert": nrm(ks[23], (L, D, N_EXPERTS), D ** -0.5),
        "b_expert": nrm(ks[24], (L, N_EXPERTS), 0.01),
        "w_gate_e": nrm(ks[25], (L, N_EXPERTS, D, D_EXPERT), D ** -0.5),
        "w_up_e": nrm(ks[26], (L, N_EXPERTS, D, D_EXPERT), D ** -0.5),
        "w_down_e": nrm(ks[27], (L, N_EXPERTS, D_EXPERT, D), D_EXPERT ** -0.5),
        "ln_ple": gain(ks[28], (L, D)),
        "w_ple_gate": nrm(ks[29], (L, D, D), D ** -0.5),
        "w_ple_proj": nrm(ks[30], (L, PLE_DIM, D), PLE_DIM ** -0.5),
        "ln_final": gain(ks[31], (D,)),
    }


def reference(x, p, positions, ln_mix, w_in, mu_shift, w0, w_decay_up, a0, w_aaa_up, w_gate_up,
              k_k, k_a, r_k, ln_x_w, ln_x_b, sinks, w_branch_att, w_branch_rwkv, w_out,
              ln_moe, w_group, b_group, w_expert, b_expert, w_gate_e, w_up_e, w_down_e,
              ln_ple, w_ple_gate, w_ple_proj, ln_final):
    B, S, D = x.shape
    for i in range(DEPTH):
        h = rmsnorm(x, ln_mix[i])
        z = h @ w_in[i]
        z_att = z[..., :ATT_COLS]
        z_rwkv = token_shift(z[..., ATT_COLS:ATT_COLS + SHIFT_COLS], mu_shift[i].astype(z.dtype))
        z_gate = z[..., ATT_COLS + SHIFT_COLS:]
        q = z_att[..., :ATT_WIDTH].reshape(B, S, ATT_HEADS, HEAD_DIM)
        k = z_att[..., ATT_WIDTH:ATT_WIDTH + KV_WIDTH].reshape(B, S, ATT_KV_HEADS, HEAD_DIM)
        v = z_att[..., ATT_WIDTH + KV_WIDTH:].reshape(B, S, ATT_KV_HEADS, HEAD_DIM)
        y_att = sliding_window_attention(apply_rope(q, positions), apply_rope(k, positions), v, sinks[i])
        c0 = RWKV_WIDTH
        r_b = z_rwkv[..., :c0]
        k_b = z_rwkv[..., c0:2 * c0]
        v_b = z_rwkv[..., 2 * c0:3 * c0]
        xw = z_rwkv[..., 3 * c0:3 * c0 + DECAY_LORA]
        xa = z_rwkv[..., 3 * c0 + DECAY_LORA:3 * c0 + DECAY_LORA + AAA_LORA]
        xg = z_rwkv[..., 3 * c0 + DECAY_LORA + AAA_LORA:]
        y_rwkv = rwkv7_time_mix(r_b, k_b, v_b, xw, xa, xg, w0[i], w_decay_up[i], a0[i], w_aaa_up[i],
                                w_gate_up[i], k_k[i], k_a[i], r_k[i], ln_x_w[i], ln_x_b[i]).astype(x.dtype)
        gates = jax.nn.sigmoid(z_gate.astype(jnp.float32)).astype(x.dtype)
        merged = gates[..., :D] * (y_att @ w_branch_att[i]) + gates[..., D:] * (y_rwkv @ w_branch_rwkv[i])
        x = x + merged @ w_out[i]
        x = x + hierarchical_moe(rmsnorm(x, ln_moe[i]), w_group[i], b_group[i], w_expert[i], b_expert[i],
                                 w_gate_e[i], w_up_e[i], w_down_e[i])
        ple_gate = jax.nn.sigmoid((rmsnorm(x, ln_ple[i]) @ w_ple_gate[i]).astype(jnp.float32)).astype(x.dtype)
        x = x + ple_gate * (p[i] @ w_ple_proj[i])
    return rmsnorm(x, ln_final)
```

```cpp
#include <hip/hip_runtime.h>
#include <hip/hip_bf16.h>
#include <cstdio>
#include <cstdint>
#include <cmath>

#ifndef MK_SINGLE
#define MK_SINGLE 0
#endif

namespace pg8 {
#define PG8_LAS __attribute__((address_space(3)))
typedef unsigned short bf16_t;
typedef short bf16x8 __attribute__((ext_vector_type(8)));
typedef float f32x4 __attribute__((ext_vector_type(4)));
typedef unsigned u32x4 __attribute__((ext_vector_type(4)));
constexpr int BM = 256, BK = 64, HALF = 128, HTB = HALF * BK * 2  , STAGE_BYTES = 8 * HTB, NXCD = 8, WGM = 8;

__host__ __device__ __forceinline__ int lds_byte(int r, int c) { const int st = (r >> 4) * 2 + (c >> 5), rr = r & 15, cc = c & 31, ob = rr * 64 + cc * 2; return st * 1024 + (ob ^ (((ob >> 9) & 1) << 5)); }
__host__ __device__ __forceinline__ void stage_rc(int b, int& R, int& C) { const int st = b / 1024, sb = b % 1024, swz = sb ^ (((sb >> 9) & 1) << 5); R = (st >> 1) * 16 + swz / 64; C = (st & 1) * 32 + (swz % 64) / 2; }
__host__ __device__ __forceinline__ int perm32(int rho) { const int n = rho >> 4, i = rho & 15; return 8 * (i >> 2) + 4 * n + (i & 3); }

struct Unit { int pm, pn, pb; };
struct Gemm { const bf16_t* A; const bf16_t* Bt; int M, N, K; };

struct StaticOrder {
    int nM, nN, nwg, G, c;
    __host__ __device__ void init(int M, int N, int G_, int c_) { nM = M / BM; nN = N / BM; nwg = nM * nN; G = G_; c = c_; }
    __host__ __device__ bool next(int i, Unit& u) const {
        const long L = (long)i * G + c; if (L >= nwg) return false;
        int wgid = (int)L; { const int q = nwg / NXCD, r = nwg % NXCD, xcd = wgid % NXCD, off = wgid / NXCD; wgid = (xcd < r ? xcd * (q + 1) : r * (q + 1) + (xcd - r) * q) + off; }
        const int nig = WGM * nN, gid = wgid / nig, fm = gid * WGM, gsz = (nM - fm) < WGM ? (nM - fm) : WGM;
        u.pm = fm + ((wgid % nig) % gsz); u.pn = (wgid % nig) / gsz; u.pb = u.pn; return true;
    }
    __device__ __forceinline__ void a_ready(const Unit&) const {}
    __device__ __forceinline__ void done(const Unit&) const {}
};

template <class Epi, class Sched, bool ALIGN_EPI = false, bool SP2 = false>
__device__ __forceinline__ void gemm_phase(PG8_LAS unsigned char* lds, const Gemm g, const Sched& S, const Epi& E) {
    int tid_ = threadIdx.x; asm volatile("" : "+v"(tid_));
    const int tid = tid_, wid = __builtin_amdgcn_readfirstlane(tid >> 6), lane = tid & 63, wr = wid >> 2, wc = wid & 3, fr = lane & 15, fq = lane >> 4;
    const int K = g.K, nt = K / BK;
    unsigned voffA[2], voffB[2];
#pragma unroll
    for (int i = 0; i < 2; ++i) { int R, C; stage_rc(tid * 16 + i * 8192, R, C); const int Rb = Epi::PERM ? ((R & ~31) + perm32(R & 31)) : R;
        voffA[i] = (unsigned)(R * K + C) * 2u; voffB[i] = (unsigned)(Rb * K + C) * 2u; }
    const size_t kstep = (size_t)(BK * 2);
    const size_t hstep = (size_t)HALF * K * 2;
    const size_t tstep = 2 * hstep;
    const unsigned ldsw = (unsigned)wid * 1024u;
    const int aoff = lds_byte(wr * 64 + fr, fq * 8), boff = lds_byte(wc * 32 + fr, fq * 8);
#define PG8_SA(b, h) (((b) * 2 + (h)) * HTB)
#define PG8_SB(b, h) ((4 + (b) * 2 + (h)) * HTB)
#define PG8_STAGE(bufoff, gbase, voff) do { _Pragma("unroll") for (int _i = 0; _i < 2; ++_i) \
        __builtin_amdgcn_global_load_lds((const unsigned*)((const char*)(gbase) + (voff)[_i]), (PG8_LAS unsigned*)(lds + (bufoff) + ldsw + _i * 8192), 16, 0, 0); } while (0)
#define PG8_LDA(dst, b, h) do { _Pragma("unroll") for (int m = 0; m < 4; ++m) _Pragma("unroll") for (int k = 0; k < 2; ++k) dst[m][k] = *(const PG8_LAS bf16x8*)(lds + PG8_SA(b, h) + aoff + m * 2048 + k * 1024); } while (0)
#define PG8_LDB(dst, b, h) do { _Pragma("unroll") for (int n = 0; n < 2; ++n) _Pragma("unroll") for (int k = 0; k < 2; ++k) dst[n][k] = *(const PG8_LAS bf16x8*)(lds + PG8_SB(b, h) + boff + n * 2048 + k * 1024); } while (0)
#define PG8_MMA(ai, bj, At, Bt) do { __builtin_amdgcn_s_setprio(1); _Pragma("unroll") for (int m = 0; m < 4; ++m) _Pragma("unroll") for (int n = 0; n < 2; ++n) _Pragma("unroll") for (int k = 0; k < 2; ++k) \
        acc[ai][bj][m][n] = __builtin_amdgcn_mfma_f32_16x16x32_bf16(Bt[n][k], At[m][k], acc[ai][bj][m][n], 0, 0, 0); __builtin_amdgcn_s_setprio(0); } while (0)
#define PG8_WAIT_V(n) asm volatile("s_waitcnt vmcnt(" #n ")" ::: "memory")
#define PG8_WAIT_L(n) asm volatile("s_waitcnt lgkmcnt(" #n ")" ::: "memory")
#define PG8_BAR __builtin_amdgcn_s_barrier()
#define PG8_SCHED __builtin_amdgcn_sched_barrier(0)
    Unit cur, nxt; int ui = 0;
    if (!S.next(0, cur)) return;
    f32x4 acc[2][2][4][2];
#pragma unroll
    for (int a = 0; a < 2; ++a)
#pragma unroll
        for (int b = 0; b < 2; ++b)
#pragma unroll
            for (int m = 0; m < 4; ++m)
#pragma unroll
                for (int n = 0; n < 2; ++n) acc[a][b][m][n] = (f32x4){0.f, 0.f, 0.f, 0.f};
    bf16x8 At[4][2], B0[2][2], B1[2][2];
    const char* cA = (const char*)g.A + (size_t)cur.pm * tstep; const char* cB = (const char*)g.Bt + (size_t)cur.pb * tstep;
    S.a_ready(cur);
    if constexpr (SP2) {
        PG8_STAGE(PG8_SB(0, 0), cB, voffB); PG8_STAGE(PG8_SB(0, 1), cB + hstep, voffB); PG8_STAGE(PG8_SA(0, 0), cA, voffA); PG8_STAGE(PG8_SA(0, 1), cA + hstep, voffA);
        if (wr == 1) PG8_BAR;
        PG8_WAIT_V(2); PG8_BAR;
        PG8_STAGE(PG8_SB(1, 0), cB + kstep, voffB); PG8_STAGE(PG8_SA(1, 0), cA + kstep, voffA); PG8_STAGE(PG8_SB(1, 1), cB + hstep + kstep, voffB);
        PG8_WAIT_V(6); PG8_BAR;
    } else {
        PG8_STAGE(PG8_SB(0, 0), cB, voffB); PG8_STAGE(PG8_SA(0, 0), cA, voffA); PG8_STAGE(PG8_SB(0, 1), cB + hstep, voffB); PG8_STAGE(PG8_SA(0, 1), cA + hstep, voffA);
        if (wr == 1) PG8_BAR;
        PG8_WAIT_V(4); PG8_BAR;
        PG8_STAGE(PG8_SB(1, 0), cB + kstep, voffB); PG8_STAGE(PG8_SA(1, 0), cA + kstep, voffA); PG8_STAGE(PG8_SB(1, 1), cB + hstep + kstep, voffB);
        PG8_WAIT_V(6); PG8_BAR;
    }
    for (;;) {
        const bool has_next = S.next(ui + 1, nxt);
        const char* nA = has_next ? (const char*)g.A + (size_t)nxt.pm * tstep : cA; const char* nB = has_next ? (const char*)g.Bt + (size_t)nxt.pb * tstep : cB;
        for (int t = 0; t < nt; t += 2) {
            const bool last = (t == nt - 2);
            const char* a1 = cA + (size_t)(t + 1) * kstep;
            const char* a2 = last ? nA : cA + (size_t)(t + 2) * kstep; const char* b2 = last ? nB : cB + (size_t)(t + 2) * kstep;
            const char* a3 = a2 + kstep; const char* b3 = b2 + kstep;
            if (last && has_next) S.a_ready(nxt);
            if constexpr (SP2) {
            PG8_LDB(B0, 0, 0); PG8_LDB(B1, 0, 1); PG8_SCHED; PG8_LDA(At, 0, 0); PG8_STAGE(PG8_SA(1, 1), a1 + hstep, voffA);
            PG8_WAIT_V(8); PG8_WAIT_L(0); PG8_BAR; PG8_MMA(0, 0, At, B0); PG8_MMA(0, 1, At, B1); PG8_BAR; PG8_SCHED;
            PG8_LDA(At, 0, 1); PG8_STAGE(PG8_SB(0, 0), b2, voffB); PG8_STAGE(PG8_SB(0, 1), b2 + hstep, voffB); PG8_STAGE(PG8_SA(0, 0), a2, voffA);
            PG8_WAIT_V(8); PG8_WAIT_L(0); PG8_BAR; PG8_MMA(1, 0, At, B0); PG8_MMA(1, 1, At, B1); PG8_BAR; PG8_SCHED;
            PG8_LDB(B0, 1, 0); PG8_LDB(B1, 1, 1); PG8_SCHED; PG8_LDA(At, 1, 0); PG8_STAGE(PG8_SA(0, 1), a2 + hstep, voffA);
            PG8_WAIT_V(8); PG8_WAIT_L(0); PG8_BAR; PG8_MMA(0, 0, At, B0); PG8_MMA(0, 1, At, B1); PG8_BAR; PG8_SCHED;
            PG8_LDA(At, 1, 1); PG8_STAGE(PG8_SB(1, 0), b3, voffB); PG8_STAGE(PG8_SB(1, 1), b3 + hstep, voffB); PG8_STAGE(PG8_SA(1, 0), a3, voffA);
            PG8_WAIT_V(8); PG8_WAIT_L(0); PG8_BAR; PG8_MMA(1, 0, At, B0); PG8_MMA(1, 1, At, B1); PG8_BAR; PG8_SCHED;
            } else {
            PG8_LDB(B0, 0, 0); PG8_SCHED; PG8_LDA(At, 0, 0); PG8_STAGE(PG8_SA(1, 1), a1 + hstep, voffA);
            PG8_WAIT_L(8); PG8_BAR; PG8_WAIT_L(0); PG8_MMA(0, 0, At, B0); PG8_BAR; PG8_SCHED;
            PG8_LDB(B1, 0, 1); PG8_STAGE(PG8_SB(0, 0), b2, voffB);
            PG8_BAR; PG8_WAIT_L(0); PG8_MMA(0, 1, At, B1); PG8_BAR;
            PG8_LDA(At, 0, 1); PG8_STAGE(PG8_SA(0, 0), a2, voffA);
            PG8_BAR; PG8_WAIT_L(0); PG8_MMA(1, 0, At, B0); PG8_BAR; PG8_SCHED;
            PG8_STAGE(PG8_SB(0, 1), b2 + hstep, voffB);
            PG8_WAIT_V(6); PG8_BAR; PG8_MMA(1, 1, At, B1); PG8_BAR;
            PG8_LDB(B0, 1, 0); PG8_SCHED; PG8_LDA(At, 1, 0); PG8_STAGE(PG8_SA(0, 1), a2 + hstep, voffA);
            PG8_WAIT_L(8); PG8_BAR; PG8_WAIT_L(0); PG8_MMA(0, 0, At, B0); PG8_BAR; PG8_SCHED;
            PG8_LDB(B1, 1, 1); PG8_STAGE(PG8_SB(1, 0), b3, voffB);
            PG8_BAR; PG8_WAIT_L(0); PG8_MMA(0, 1, At, B1); PG8_BAR;
            PG8_LDA(At, 1, 1); PG8_STAGE(PG8_SA(1, 0), a3, voffA);
            PG8_BAR; PG8_WAIT_L(0); PG8_MMA(1, 0, At, B0); PG8_BAR; PG8_SCHED;
            PG8_STAGE(PG8_SB(1, 1), b3 + hstep, voffB);
            PG8_WAIT_V(6); PG8_BAR; PG8_MMA(1, 1, At, B1); PG8_BAR;
            }
        }
        if constexpr (ALIGN_EPI) { if (wr == 0) PG8_BAR; }
        if constexpr (!Epi::AFTER_DRAIN) { E(acc, cur, wr, wc, fr, fq); S.done(cur); }
        if (!has_next) break;
#pragma unroll
        for (int a = 0; a < 2; ++a)
#pragma unroll
            for (int b = 0; b < 2; ++b)
#pragma unroll
                for (int m = 0; m < 4; ++m)
#pragma unroll
                    for (int n = 0; n < 2; ++n) acc[a][b][m][n] = (f32x4){0.f, 0.f, 0.f, 0.f};
        cur = nxt; cA = nA; cB = nB; ++ui;
        if constexpr (ALIGN_EPI) { if (wr == 1) PG8_BAR; }
    }
    PG8_WAIT_V(0);
    if constexpr (!ALIGN_EPI) { if (wr == 0) PG8_BAR; }
    PG8_BAR;
    if constexpr (Epi::AFTER_DRAIN) { E.fused(acc, cur, wr, wc, fr, fq, lds, wid, lane); S.done(cur); }
#undef PG8_SA
#undef PG8_SB
#undef PG8_STAGE
#undef PG8_LDA
#undef PG8_LDB
#undef PG8_MMA
#undef PG8_WAIT_V
#undef PG8_WAIT_L
#undef PG8_BAR
#undef PG8_SCHED
}
}
#define GAS __attribute__((address_space(1)))
#define LAS __attribute__((address_space(3)))
typedef unsigned short bf16;
typedef unsigned v4u __attribute__((ext_vector_type(4)));
typedef float f32x4 __attribute__((ext_vector_type(4)));
typedef short bf16x8 __attribute__((ext_vector_type(8)));
typedef GAS unsigned gu32;
typedef GAS unsigned long long gu64;
#define RLX_AGENT __ATOMIC_RELAXED, __HIP_MEMORY_SCOPE_AGENT
#define LDS_WAIT() asm volatile("s_waitcnt lgkmcnt(0)" ::: "memory")
#define VM_WAIT() asm volatile("s_waitcnt vmcnt(0)" ::: "memory")
__device__ __forceinline__ unsigned long long rt() { return __builtin_amdgcn_s_memrealtime(); }
__device__ __forceinline__ unsigned f2bf(float f) { unsigned u = __builtin_bit_cast(unsigned, f); return (u + 0x7fffu + ((u >> 16) & 1u)) >> 16; }
__device__ __forceinline__ unsigned pk2(float lo, float hi) { return f2bf(lo) | (f2bf(hi) << 16); }

#define XB_TMO      128
#define XB_XCNT(j)  (256  + 64 * (j))
#define XB_XSUB(j)  (1280 + 64 * (j))
#define XB_XGEN(j)  (2304 + 64 * (j))
#define XB_TOP      3328
#define XB_TOPGEN   3392
#define XCD_BAR_WORDS 3456
#define XB_SPIN_CAP (1u << 18)

__device__ __forceinline__ unsigned xb_ld(unsigned* p)              { return __hip_atomic_load(p, __ATOMIC_RELAXED, __HIP_MEMORY_SCOPE_AGENT); }
__device__ __forceinline__ unsigned xb_add(unsigned* p, unsigned v) { return __hip_atomic_fetch_add(p, v, __ATOMIC_RELAXED, __HIP_MEMORY_SCOPE_AGENT); }
__device__ __forceinline__ unsigned xb_xcc_id() { return (unsigned)__builtin_amdgcn_s_getreg((3 << 11) | 20) & 0xFu; }
#define XB_SPIN(cond, bar) do { unsigned _sp = 0; while (cond) { __builtin_amdgcn_s_sleep(1); \
    if ((++_sp & 255u) == 0u) { if (xb_ld(&(bar)[XB_TMO])) break; if (_sp > XB_SPIN_CAP) { atomicAdd(&(bar)[XB_TMO], 1u); break; } } } } while (0)

struct XcdBarrier {
    unsigned* bar; unsigned x;
    volatile LAS unsigned* st;
};

__device__ __forceinline__ XcdBarrier xcd_barrier_post(unsigned* bar, volatile LAS unsigned* st) {
    XcdBarrier b; b.bar = bar; b.x = xb_xcc_id(); b.st = st;
    if (threadIdx.x == 0) (void)xb_add(&bar[XB_XCNT(b.x)], 1u);
    return b;
}
__device__ __forceinline__ void xcd_barrier_complete(unsigned* bar, unsigned x, unsigned& nloc, unsigned& nx) {
    const unsigned G = gridDim.x * gridDim.y * gridDim.z;
    unsigned sum, cnt, mine, sp = 0u;
    for (;;) {
        sum = 0u; cnt = 0u; mine = 0u;
#pragma unroll
        for (unsigned j = 0; j < 16; ++j) { const unsigned c = xb_ld(&bar[XB_XCNT(j)]); sum += c; cnt += (c > 0u) ? 1u : 0u; mine = (j == x) ? c : mine; }
        if (sum == G) break;
        __builtin_amdgcn_s_sleep(1);
        if ((++sp & 255u) == 0u) { if (xb_ld(&bar[XB_TMO])) break; if (sp > XB_SPIN_CAP) { atomicAdd(&bar[XB_TMO], 1u); break; } }
    }
    nloc = mine > 0u ? mine : 1u; nx = cnt > 0u ? cnt : 1u;
}

__device__ __forceinline__ void xcd_barrier(const XcdBarrier& b) {
    asm volatile("s_waitcnt vmcnt(0)" ::: "memory");
    __syncthreads();
    if (threadIdx.x == 0) {
        unsigned* bar = b.bar;
        __builtin_amdgcn_s_waitcnt(0);
        unsigned nloc = b.st[0], nx = b.st[1];
        if (nloc == 0u) { xcd_barrier_complete(bar, b.x, nloc, nx); b.st[0] = nloc; b.st[1] = nx; }
        const unsigned old = xb_add(&bar[XB_XSUB(b.x)], 1u);
        const unsigned gen = old / nloc;
        if (old + 1u == (gen + 1u) * nloc) {
            __builtin_amdgcn_fence(__ATOMIC_RELEASE, "agent");
            asm volatile("s_waitcnt vmcnt(0)" ::: "memory");
            const unsigned og = xb_add(&bar[XB_TOP], 1u);
            const unsigned tg = og / nx;
            if (og + 1u == (tg + 1u) * nx) xb_add(&bar[XB_TOPGEN], 1u);
            else XB_SPIN(xb_ld(&bar[XB_TOPGEN]) == tg, bar);
            __builtin_amdgcn_fence(__ATOMIC_ACQUIRE, "agent");
            xb_add(&bar[XB_XGEN(b.x)], 1u);
            asm volatile("s_waitcnt vmcnt(0)" ::: "memory");
        } else {
            XB_SPIN(xb_ld(&bar[XB_XGEN(b.x)]) == gen, bar);
            __builtin_amdgcn_fence(__ATOMIC_ACQUIRE, "agent");
            asm volatile("s_waitcnt vmcnt(0)" ::: "memory");
        }
    }
    __syncthreads();
}

constexpr int NWAVES = 8;
constexpr int BATCH = 32, SEQ = 2048, DM = 1024, T = BATCH * SEQ;
constexpr int PLE = 256, NIN = 4608, NSHIFT = 1792, CW = 512;
constexpr int NEXP = 32, DEXP = 512;
constexpr int PMAX = 2 * T + NEXP * 256;
constexpr int NRT_MAX = PMAX / 256;
constexpr float NORM_EPS = 1e-6f, GN_EPS = 64e-5f;
constexpr float LOG2E = 1.4426950408889634f;
constexpr float QSCALE = 0.125f * LOG2E;

constexpr size_t MiB = 1u << 20;
constexpr size_t WS_CTL = 0, CTL_ZERO_BYTES = 65536;
constexpr size_t WS_RSTD1 = 1 * MiB, WS_RSTD2 = 1 * MiB + 256 * 1024, WS_RSTD3 = 1 * MiB + 512 * 1024;
constexpr size_t WS_WIN = 2 * MiB, WS_WBA = 11 * MiB, WS_WBB = 12 * MiB, WS_WOUT = 13 * MiB, WS_WR = 15 * MiB, WS_WL = 15 * MiB + 512 * 1024;
constexpr size_t WS_WPP = 16 * MiB + 512 * 1024, WS_WPG = 17 * MiB, WS_WGU = 19 * MiB, WS_WD = 83 * MiB;
constexpr size_t WS_SSQ2 = 115 * MiB, WS_SSQ4 = 119 * MiB;
constexpr size_t WS_RT_E = 123 * MiB, WS_RT_W = 123 * MiB + 512 * 1024, WS_RT_RANK = 124 * MiB, WS_RT_POS = 124 * MiB + 512 * 1024;
constexpr size_t WS_ROWSCALE = 125 * MiB;
constexpr size_t WS_TABLE = 126 * MiB;
constexpr size_t WS_META = 126 * MiB + 256 * 1024;
constexpr size_t WS_PB = 128 * MiB, WS_XB = 160 * MiB;
constexpr size_t WS_QB = 288 * MiB, WS_KB = 352 * MiB, WS_VB = 368 * MiB, WS_ZS = 384 * MiB;
constexpr size_t WS_R = 608 * MiB, WS_KR = 672 * MiB, WS_VR = 736 * MiB, WS_KK = 800 * MiB, WS_LIN = 864 * MiB;
constexpr size_t WS_ROPE = 608 * MiB;
constexpr size_t WS_DEC = 384 * MiB, WS_BB = 512 * MiB, WS_GG = 896 * MiB, WS_YATT = 960 * MiB;
constexpr size_t WS_YRW = 288 * MiB, WS_MRG = 384 * MiB;
constexpr size_t WS_X1 = 608 * MiB;
constexpr size_t WS_LOG = 560 * MiB;
constexpr size_t WS_XS = 288 * MiB, WS_HID = 864 * MiB, WS_Y = 288 * MiB, WS_PP = 864 * MiB;
constexpr size_t WS_END = 1024 * MiB;
static_assert(WS_XS + (size_t)PMAX * DM * 2 <= WS_LOG && WS_HID + (size_t)PMAX * DEXP * 2 <= WS_END, "ws map");
constexpr int CW_BAR = 4096;

constexpr int RING_OFF = 0, RING_BYTES = 131072;
constexpr int LDSCTL_OFF = RING_BYTES, MISC_OFF = LDSCTL_OFF + 320;
constexpr int TILEE_OFF = RING_BYTES + 1024;
constexpr int LDS_BYTES = 147456;

typedef float f32x2 __attribute__((ext_vector_type(2)));
typedef float f32x16 __attribute__((ext_vector_type(16)));
typedef unsigned u32x2 __attribute__((ext_vector_type(2)));
typedef short s16x4 __attribute__((ext_vector_type(4)));

struct Frame {
    LAS unsigned char* lds;
    volatile LAS unsigned* MISC;
    gu32* ctl;
    int tid, lane, wave;
    int vcu, G;
    unsigned char* ws;
    float* out;
    const void* const* in;
};
#define INF(i) ((const float*)F.in[i])
#define WSP(type, off) ((type*)(F.ws + (off)))

__device__ __forceinline__ float wave_sum(float v) {
#pragma unroll
    for (int o = 1; o < 64; o <<= 1) v += __shfl_xor(v, o);
    return v;
}
__device__ __forceinline__ unsigned cvt_pk(float lo, float hi) { unsigned r; asm volatile("v_cvt_pk_bf16_f32 %0, %1, %2" : "=v"(r) : "v"(lo), "v"(hi)); return r; }
__device__ __forceinline__ float bflo(unsigned w) { return __uint_as_float(w << 16); }
__device__ __forceinline__ float bfhi(unsigned w) { return __uint_as_float(w & 0xffff0000u); }
__device__ __forceinline__ float bf1(unsigned short h) { return __uint_as_float((unsigned)h << 16); }
__device__ __forceinline__ float sigmoidf_(float x) { return __builtin_amdgcn_rcpf(1.0f + __expf(-x)); }
__device__ __forceinline__ u32x2 pack4(f32x4 v) { u32x2 w; w.x = cvt_pk(v[0], v[1]); w.y = cvt_pk(v[2], v[3]); return w; }
__device__ __forceinline__ f32x4 unpack4(u32x2 w) { return (f32x4){bflo(w.x), bfhi(w.x), bflo(w.y), bfhi(w.y)}; }

__device__ __forceinline__ int dest_row(int mode, int rowbase, int n) {
    if (mode == 0) return rowbase + n;
    if (mode == 1) { if (n >= 640) return n; const int d = n & 63; return (n & ~63) + 32 * ((d & 31) >> 4) + 16 * (d >> 5) + (d & 15); }
    if (mode == 2) return rowbase + 256 * (n >> 7) + (n & 127);
    return rowbase + 256 * (n >> 7) + 128 + (n & 127);
}
__device__ __forceinline__ void p0_transpose_item(const float* W, int K, int N, bf16* WT, int mode, int rowbase, const float* kscale, LAS float* scr, int item, int lane) {
    const int nblk = N / 32, kb = item / nblk, nb = item % nblk, k0 = 64 * kb, n0 = 32 * nb;
#pragma unroll 8
    for (int i = 0; i < 32; ++i) { const int kk = 2 * i + (lane >> 5); float v = W[(size_t)(k0 + kk) * N + n0 + (lane & 31)]; if (kscale) v *= kscale[k0 + kk]; scr[kk * 33 + (lane & 31)] = v; }
    LDS_WAIT(); asm volatile("" ::: "memory");
    const int c = lane & 7;
#pragma unroll
    for (int j = 0; j < 4; ++j) { const int n = (lane >> 3) + 8 * j; const LAS float* s = scr + (8 * c) * 33 + n;
        v4u o; o.x = pk2(s[0 * 33], s[1 * 33]); o.y = pk2(s[2 * 33], s[3 * 33]); o.z = pk2(s[4 * 33], s[5 * 33]); o.w = pk2(s[6 * 33], s[7 * 33]);
        *(GAS v4u*)(WT + (size_t)dest_row(mode, rowbase, n0 + n) * K + k0 + 8 * c) = o; }
    LDS_WAIT(); asm volatile("" ::: "memory");
}

__device__ __forceinline__ void p0_prologue(Frame& F) {
    LAS float* scr = (LAS float*)(F.lds + RING_OFF + F.wave * 16384);
    const int gw = F.vcu * NWAVES + F.wave, NGW = F.G * NWAVES, lane = F.lane;
    constexpr int I_WIN = 16 * 144, I_WB = 8 * 32, I_WO = 16 * 32, I_PP = 4 * 32, I_EG = 16 * 16, I_ED = 8 * 32;
    constexpr int NITEMS = I_WIN + 2 * I_WB + 2 * I_WO + I_PP + NEXP * (2 * I_EG + I_ED);
    for (int it = gw; it < NITEMS; it += NGW) {
        int r = it;
        if (r < I_WIN) { p0_transpose_item(INF(4), DM, NIN, WSP(bf16, WS_WIN), 1, 0, INF(3), scr, r, lane); continue; } r -= I_WIN;
        if (r < I_WB) { p0_transpose_item(INF(17), CW, DM, WSP(bf16, WS_WBA), 0, 0, nullptr, scr, r, lane); continue; } r -= I_WB;
        if (r < I_WB) { p0_transpose_item(INF(18), CW, DM, WSP(bf16, WS_WBB), 0, 0, nullptr, scr, r, lane); continue; } r -= I_WB;
        if (r < I_WO) { p0_transpose_item(INF(19), DM, DM, WSP(bf16, WS_WOUT), 0, 0, nullptr, scr, r, lane); continue; } r -= I_WO;
        if (r < I_WO) { p0_transpose_item(INF(29), DM, DM, WSP(bf16, WS_WPG), 0, 0, INF(28), scr, r, lane); continue; } r -= I_WO;
        if (r < I_PP) { p0_transpose_item(INF(30), PLE, DM, WSP(bf16, WS_WPP), 0, 0, nullptr, scr, r, lane); continue; } r -= I_PP;
        if (r < NEXP * I_EG) { const int e = r / I_EG; p0_transpose_item(INF(25) + (size_t)e * DM * DEXP, DM, DEXP, WSP(bf16, WS_WGU), 2, e * 1024, INF(20), scr, r % I_EG, lane); continue; } r -= NEXP * I_EG;
        if (r < NEXP * I_EG) { const int e = r / I_EG; p0_transpose_item(INF(26) + (size_t)e * DM * DEXP, DM, DEXP, WSP(bf16, WS_WGU), 3, e * 1024, INF(20), scr, r % I_EG, lane); continue; } r -= NEXP * I_EG;
        { const int e = r / I_ED; p0_transpose_item(INF(27) + (size_t)e * DEXP * DM, DEXP, DM, WSP(bf16, WS_WD), 0, e * 1024, nullptr, scr, r % I_ED, lane); }
    }
    const int gt = F.vcu * (NWAVES * 64) + F.tid, NGT = F.G * NWAVES * 64;
    for (int it = gt; it < 1536 * 32; it += NGT) {
        const int row = it >> 5, k8 = (it & 31) * 8; const int blk = row >> 9, n = row & 511;
        float v[8];
#pragma unroll
        for (int j = 0; j < 8; ++j) { const int k = k8 + j; float x = 0.f;
            if (blk == 0 && k < 64) x = INF(7)[(size_t)k * CW + n];
            else if (blk == 1 && k >= 64 && k < 128) x = INF(9)[(size_t)(k - 64) * CW + n];
            else if (blk == 2 && k >= 128) x = INF(10)[(size_t)(k - 128) * CW + n];
            v[j] = x; }
        v4u o; o.x = pk2(v[0], v[1]); o.y = pk2(v[2], v[3]); o.z = pk2(v[4], v[5]); o.w = pk2(v[6], v[7]);
        *(GAS v4u*)(WSP(bf16, WS_WL) + (size_t)row * 256 + k8) = o;
    }
    for (int it = gt; it < 256 * 128; it += NGT) {
        const int row = it >> 7, k8 = (it & 127) * 8; float v[8];
#pragma unroll
        for (int j = 0; j < 8; ++j) { const int k = k8 + j; float x = 0.f;
            if (row < 4) x = INF(21)[(size_t)k * 4 + row] * INF(20)[k];
            else if (row < 36) x = INF(23)[(size_t)k * NEXP + (row - 4)] * INF(20)[k];
            v[j] = x; }
        v4u o; o.x = pk2(v[0], v[1]); o.y = pk2(v[2], v[3]); o.z = pk2(v[4], v[5]); o.w = pk2(v[6], v[7]);
        *(GAS v4u*)(WSP(bf16, WS_WR) + (size_t)row * DM + k8) = o;
    }
    for (int it = gt; it < T * PLE / 8; it += NGT) {
        const GAS f32x4* s = (const GAS f32x4*)INF(1) + (size_t)it * 2; const f32x4 a = s[0], b = s[1];
        v4u o; o.x = pk2(a[0], a[1]); o.y = pk2(a[2], a[3]); o.z = pk2(b[0], b[1]); o.w = pk2(b[2], b[3]);
        *(GAS v4u*)(WSP(bf16, WS_PB) + (size_t)it * 8) = o;
    }
    for (int it = gt; it < T * 32; it += NGT) {
        const int t = it >> 5, i = it & 31; const int pos = ((const int*)F.in[2])[t];
        const double inv = exp2(-(double)i * (13.287712379549449 / 32.0));
        double s, c; sincos((double)pos * inv, &s, &c);
        WSP(float, WS_ROPE)[(size_t)t * 64 + i] = (float)c; WSP(float, WS_ROPE)[(size_t)t * 64 + 32 + i] = (float)s;
    }
    for (int m = gw; m < T; m += NGW) {
        const GAS f32x4* xr = (const GAS f32x4*)(INF(0) + (size_t)m * DM) + lane;
        f32x4 v[4]; float s = 0.f;
#pragma unroll
        for (int j = 0; j < 4; ++j) { v[j] = xr[64 * j]; s += (v[j].x * v[j].x + v[j].y * v[j].y) + (v[j].z * v[j].z + v[j].w * v[j].w); }
        s = wave_sum(s);
        if (lane == 0) WSP(float, WS_RSTD1)[m] = 1.0f / sqrtf(s * (1.0f / DM) + NORM_EPS);
        GAS unsigned long long* o8 = (GAS unsigned long long*)(WSP(bf16, WS_XB) + (size_t)m * DM) + lane;
#pragma unroll
        for (int j = 0; j < 4; ++j) o8[64 * j] = (unsigned long long)pk2(v[j].x, v[j].y) | ((unsigned long long)pk2(v[j].z, v[j].w) << 32);
    }
}

#define EPI_LOOP_ROWS for (int ai = 0; ai < 2; ++ai) _Pragma("unroll") for (int m = 0; m < 4; ++m)

struct EpiZ {
    static constexpr bool PERM = false, AFTER_DRAIN = false;
    const float* rstd; const float* rope; bf16 *Qb, *Kb, *Vb, *Zs, *Gt;
    __device__ __forceinline__ void operator()(const f32x4 (&acc)[2][2][4][2], const pg8::Unit& u, int wr, int wc, int fr, int fq) const {
        const int pn = u.pn; const int row0 = u.pm * 256 + wr * 64 + fr;
        if (pn < 3) {
#pragma unroll
            EPI_LOOP_ROWS { const int row = row0 + ai * 128 + m * 16; const float rs = rstd[row];
                const int d0 = 16 * (wc & 1) + 4 * fq;
                const f32x4 cs = *(const f32x4*)(rope + (size_t)row * 64 + d0), sn = *(const f32x4*)(rope + (size_t)row * 64 + 32 + d0);
#pragma unroll
                for (int bj = 0; bj < 2; ++bj) { const f32x4 v0 = acc[ai][bj][m][0] * rs, v1 = acc[ai][bj][m][1] * rs;
                    if (pn < 2) { const int head = pn * 4 + bj * 2 + (wc >> 1); const f32x4 o0 = (v0 * cs - v1 * sn) * QSCALE, o1 = (v1 * cs + v0 * sn) * QSCALE;
                        bf16* p = Qb + (size_t)row * CW + head * 64 + d0; *(u32x2*)p = pack4(o0); *(u32x2*)(p + 32) = pack4(o1); }
                    else if (bj == 0) { const int kvh = wc >> 1; const f32x4 o0 = v0 * cs - v1 * sn, o1 = v1 * cs + v0 * sn;
                        bf16* p = Kb + (size_t)row * 128 + kvh * 64 + d0; *(u32x2*)p = pack4(o0); *(u32x2*)(p + 32) = pack4(o1); }
                    else { bf16* p = Vb + (size_t)row * 128 + wc * 32 + 4 * fq; *(u32x2*)p = pack4(v0); *(u32x2*)(p + 16) = pack4(v1); } } }
        } else if (pn < 10) {
#pragma unroll
            EPI_LOOP_ROWS { const int row = row0 + ai * 128 + m * 16; const float rs = rstd[row];
#pragma unroll
                for (int bj = 0; bj < 2; ++bj) { bf16* p = Zs + (size_t)row * NSHIFT + (pn - 3) * 256 + bj * 128 + wc * 32 + 4 * fq;
                    *(u32x2*)p = pack4(acc[ai][bj][m][0] * rs); *(u32x2*)(p + 16) = pack4(acc[ai][bj][m][1] * rs); } }
        } else {
#pragma unroll
            EPI_LOOP_ROWS { const int row = row0 + ai * 128 + m * 16; const float rs = rstd[row];
#pragma unroll
                for (int bj = 0; bj < 2; ++bj) { bf16* p = Gt + (size_t)row * 2048 + (pn - 10) * 256 + bj * 128 + wc * 32 + 4 * fq;
#pragma unroll
                    for (int n = 0; n < 2; ++n) { const f32x4 v = acc[ai][bj][m][n] * rs; f32x4 g; g[0] = sigmoidf_(v[0]); g[1] = sigmoidf_(v[1]); g[2] = sigmoidf_(v[2]); g[3] = sigmoidf_(v[3]);
                        *(u32x2*)(p + 16 * n) = pack4(g); } } }
        }
    }
};

struct EpiLora {
    static constexpr bool PERM = false, AFTER_DRAIN = false;
    const float *w0, *a0, *k_a; float* DEC; bf16 *Kr, *KKb, *Bb, *Gg;
    __device__ __forceinline__ void operator()(const f32x4 (&acc)[2][2][4][2], const pg8::Unit& u, int wr, int wc, int fr, int fq) const {
        const int pn = u.pn; const int row0 = u.pm * 256 + wr * 64 + fr;
#pragma unroll
        EPI_LOOP_ROWS { const int row = row0 + ai * 128 + m * 16;
#pragma unroll
            for (int bj = 0; bj < 2; ++bj)
#pragma unroll
                for (int n = 0; n < 2; ++n) { const int c = (pn & 1) * 256 + bj * 128 + wc * 32 + 16 * n + 4 * fq; const f32x4 v = acc[ai][bj][m][n];
                    if (pn < 2) { const f32x4 b0 = *(const f32x4*)(w0 + c); f32x4 o;
#pragma unroll
                        for (int j = 0; j < 4; ++j) { const float y = -(b0[j] + v[j]); const float sp = fmaxf(y, 0.f) + __logf(1.0f + __expf(-fabsf(y))); const float w = -sp - 0.5f; o[j] = __expf(-__expf(w)); }
                        *(f32x4*)(DEC + (size_t)row * CW + c) = o; }
                    else if (pn < 4) { const f32x4 b0 = *(const f32x4*)(a0 + c), ka = *(const f32x4*)(k_a + c);
                        const f32x4 kr = unpack4(*(const u32x2*)(Kr + (size_t)row * CW + c)), kk = unpack4(*(const u32x2*)(KKb + (size_t)row * CW + c)); f32x4 kn, bb;
#pragma unroll
                        for (int j = 0; j < 4; ++j) { const float a = sigmoidf_(b0[j] + v[j]); kn[j] = kr[j] * (1.0f + (a - 1.0f) * ka[j]); bb[j] = kk[j] * a; }
                        *(u32x2*)(Kr + (size_t)row * CW + c) = pack4(kn); *(u32x2*)(Bb + (size_t)row * CW + c) = pack4(bb); }
                    else { *(u32x2*)(Gg + (size_t)row * CW + c) = pack4(v); } } asm volatile("" ::: "memory"); }
    }
};

template <int PASS> struct EpiMerge {
    static constexpr bool PERM = false, AFTER_DRAIN = false;
    const bf16* Gt; bf16* M;
    __device__ __forceinline__ void operator()(const f32x4 (&acc)[2][2][4][2], const pg8::Unit& u, int wr, int wc, int fr, int fq) const {
        const int row0 = u.pm * 256 + wr * 64 + fr;
#pragma unroll
        EPI_LOOP_ROWS { const int row = row0 + ai * 128 + m * 16;
#pragma unroll
            for (int bj = 0; bj < 2; ++bj)
#pragma unroll
                for (int n = 0; n < 2; ++n) { const int c = u.pn * 256 + bj * 128 + wc * 32 + 16 * n + 4 * fq;
                    const f32x4 g = unpack4(*(const u32x2*)(Gt + (size_t)row * 2048 + PASS * 1024 + c)); f32x4 o = acc[ai][bj][m][n] * g;
                    if (PASS == 1) o += unpack4(*(const u32x2*)(M + (size_t)row * DM + c));
                    *(u32x2*)(M + (size_t)row * DM + c) = pack4(o); } asm volatile("" ::: "memory"); }
    }
};

struct EpiOut {
    static constexpr bool PERM = false, AFTER_DRAIN = false;
    const float* x; float* X1; bf16* X1b; float* ssq;
    __device__ __forceinline__ void operator()(const f32x4 (&acc)[2][2][4][2], const pg8::Unit& u, int wr, int wc, int fr, int fq) const {
        const int row0 = u.pm * 256 + wr * 64 + fr;
#pragma unroll
        EPI_LOOP_ROWS { const int row = row0 + ai * 128 + m * 16; float s = 0.f;
#pragma unroll
            for (int bj = 0; bj < 2; ++bj)
#pragma unroll
                for (int n = 0; n < 2; ++n) { const int c = u.pn * 256 + bj * 128 + wc * 32 + 16 * n + 4 * fq;
                    const f32x4 o = *(const f32x4*)(x + (size_t)row * DM + c) + acc[ai][bj][m][n];
                    *(f32x4*)(X1 + (size_t)row * DM + c) = o; *(u32x2*)(X1b + (size_t)row * DM + c) = pack4(o);
                    s += (o[0] * o[0] + o[1] * o[1]) + (o[2] * o[2] + o[3] * o[3]); }
            s += __shfl_xor(s, 16); s += __shfl_xor(s, 32);
            if (fq == 0) ssq[(size_t)row * 16 + u.pn * 4 + wc] = s; asm volatile("" ::: "memory"); }
    }
};

struct EpiRouter {
    static constexpr bool PERM = false, AFTER_DRAIN = false;
    const float* ssq; const float *bg, *be; float* rstd2; float* LOG;
    __device__ __forceinline__ void operator()(const f32x4 (&acc)[2][2][4][2], const pg8::Unit& u, int wr, int wc, int fr, int fq) const {
        if (wc >= 2) return;
        const int row0 = u.pm * 256 + wr * 64 + fr;
#pragma unroll
        EPI_LOOP_ROWS { const int row = row0 + ai * 128 + m * 16;
            const f32x4 a = *(const f32x4*)(ssq + (size_t)row * 16), b = *(const f32x4*)(ssq + (size_t)row * 16 + 4), c = *(const f32x4*)(ssq + (size_t)row * 16 + 8), d = *(const f32x4*)(ssq + (size_t)row * 16 + 12);
            const float s = (((a[0] + a[1]) + (a[2] + a[3])) + ((b[0] + b[1]) + (b[2] + b[3]))) + (((c[0] + c[1]) + (c[2] + c[3])) + ((d[0] + d[1]) + (d[2] + d[3])));
            const float rs = 1.0f / sqrtf(s * (1.0f / DM) + NORM_EPS);
            if (wc == 0 && fq == 0) rstd2[row] = rs;
#pragma unroll
            for (int n = 0; n < 2; ++n) { const int c0 = wc * 32 + 16 * n + 4 * fq; if (c0 >= 36) continue; f32x4 o;
#pragma unroll
                for (int j = 0; j < 4; ++j) { const int cc = c0 + j; o[j] = acc[ai][0][m][n][j] * rs + (cc < 4 ? bg[cc] : be[cc - 4]); }
                *(f32x4*)(LOG + (size_t)row * 64 + c0) = o; } }
    }
};

struct EpiGU {
    static constexpr bool PERM = false, AFTER_DRAIN = false;
    const float* rowscale; bf16* HID;
    __device__ __forceinline__ void operator()(const f32x4 (&acc)[2][2][4][2], const pg8::Unit& u, int wr, int wc, int fr, int fq) const {
        const int row0 = u.pm * 256 + wr * 64 + fr;
#pragma unroll
        EPI_LOOP_ROWS { const int row = row0 + ai * 128 + m * 16; const float rs = rowscale[row];
#pragma unroll
            for (int n = 0; n < 2; ++n) { const f32x4 g = acc[ai][0][m][n] * rs, up = acc[ai][1][m][n] * rs; f32x4 h;
#pragma unroll
                for (int j = 0; j < 4; ++j) h[j] = g[j] * sigmoidf_(g[j]) * up[j];
                *(u32x2*)(HID + (size_t)row * DEXP + u.pn * 128 + wc * 32 + 16 * n + 4 * fq) = pack4(h); } }
    }
};

struct EpiStore {
    static constexpr bool PERM = false, AFTER_DRAIN = false;
    bf16* O; int ldc;
    __device__ __forceinline__ void operator()(const f32x4 (&acc)[2][2][4][2], const pg8::Unit& u, int wr, int wc, int fr, int fq) const {
        const int row0 = u.pm * 256 + wr * 64 + fr;
#pragma unroll
        EPI_LOOP_ROWS { const int row = row0 + ai * 128 + m * 16;
#pragma unroll
            for (int bj = 0; bj < 2; ++bj)
#pragma unroll
                for (int n = 0; n < 2; ++n) *(u32x2*)(O + (size_t)row * ldc + u.pn * 256 + bj * 128 + wc * 32 + 16 * n + 4 * fq) = pack4(acc[ai][bj][m][n]); }
    }
};

struct EpiPle {
    static constexpr bool PERM = false, AFTER_DRAIN = false;
    const float* rstd3; const float* X2; const bf16* PP; float* out; float* ssq;
    __device__ __forceinline__ void operator()(const f32x4 (&acc)[2][2][4][2], const pg8::Unit& u, int wr, int wc, int fr, int fq) const {
        const int row0 = u.pm * 256 + wr * 64 + fr;
#pragma unroll
        EPI_LOOP_ROWS { const int row = row0 + ai * 128 + m * 16; const float rs = rstd3[row]; float s = 0.f;
#pragma unroll
            for (int bj = 0; bj < 2; ++bj)
#pragma unroll
                for (int n = 0; n < 2; ++n) { const int c = u.pn * 256 + bj * 128 + wc * 32 + 16 * n + 4 * fq;
                    const f32x4 pp = unpack4(*(const u32x2*)(PP + (size_t)row * DM + c)), x2 = *(const f32x4*)(X2 + (size_t)row * DM + c), v = acc[ai][bj][m][n] * rs; f32x4 o;
#pragma unroll
                    for (int j = 0; j < 4; ++j) o[j] = x2[j] + sigmoidf_(v[j]) * pp[j];
                    *(f32x4*)(out + (size_t)row * DM + c) = o; s += (o[0] * o[0] + o[1] * o[1]) + (o[2] * o[2] + o[3] * o[3]); asm volatile("" ::: "memory"); }
            s += __shfl_xor(s, 16); s += __shfl_xor(s, 32);
            if (fq == 0) ssq[(size_t)row * 16 + u.pn * 4 + wc] = s; asm volatile("" ::: "memory"); }
    }
};

struct MoeOrder {
    int nunits, G, c; const LAS int* tile_e;
    __device__ __forceinline__ bool next(int i, pg8::Unit& u) const {
        const long L = (long)i * G + c; if (L >= nunits) return false;
        const int rt = (int)(L >> 2), pn = (int)(L & 3); u.pm = rt; u.pn = pn; u.pb = tile_e[rt] * 4 + pn; return true; }
    __device__ __forceinline__ void a_ready(const pg8::Unit&) const {}
    __device__ __forceinline__ void done(const pg8::Unit&) const {}
};

__device__ __forceinline__ void load8(const bf16* p, float (&v)[8]) { const v4u w = *(const GAS v4u*)p; v[0] = bflo(w.x); v[1] = bfhi(w.x); v[2] = bflo(w.y); v[3] = bfhi(w.y); v[4] = bflo(w.z); v[5] = bfhi(w.z); v[6] = bflo(w.w); v[7] = bfhi(w.w); }
__device__ __forceinline__ void store8(bf16* p, const float (&v)[8]) { v4u o; o.x = cvt_pk(v[0], v[1]); o.y = cvt_pk(v[2], v[3]); o.z = cvt_pk(v[4], v[5]); o.w = cvt_pk(v[6], v[7]); *(GAS v4u*)p = o; }
__device__ __forceinline__ void shift8(const bf16* Zs, int t, bool has_prev, int col, const float* mu, float (&o)[8]) {
    float c[8], p[8]; load8(Zs + (size_t)t * NSHIFT + col, c);
    if (has_prev) load8(Zs + (size_t)(t - 1) * NSHIFT + col, p); else {
#pragma unroll
        for (int j = 0; j < 8; ++j) p[j] = 0.f; }
    const f32x4 m0 = *(const f32x4*)(mu + col), m1 = *(const f32x4*)(mu + col + 4);
#pragma unroll
    for (int j = 0; j < 8; ++j) o[j] = c[j] + (p[j] - c[j]) * (j < 4 ? m0[j] : m1[j - 4]);
}
__device__ __forceinline__ void rp1_phase(Frame& F) {
    const int gw = F.vcu * NWAVES + F.wave, NGW = F.G * NWAVES, lane = F.lane;
    const bf16* Zs = WSP(bf16, WS_ZS); const float* mu = INF(5); const float* k_k = INF(11);
    for (int t = gw; t < T; t += NGW) {
        const bool hp = (t & (SEQ - 1)) != 0; float v[8];
        shift8(Zs, t, hp, 8 * lane, mu, v); store8(WSP(bf16, WS_R) + (size_t)t * CW + 8 * lane, v);
        shift8(Zs, t, hp, 1024 + 8 * lane, mu, v); store8(WSP(bf16, WS_VR) + (size_t)t * CW + 8 * lane, v);
        shift8(Zs, t, hp, 512 + 8 * lane, mu, v); store8(WSP(bf16, WS_KR) + (size_t)t * CW + 8 * lane, v);
        { const f32x4 k0 = *(const f32x4*)(k_k + 8 * lane), k1 = *(const f32x4*)(k_k + 8 * lane + 4); float ss = 0.f;
#pragma unroll
            for (int j = 0; j < 8; ++j) { v[j] *= (j < 4 ? k0[j] : k1[j - 4]); ss += v[j] * v[j]; }
            ss += __shfl_xor(ss, 1); ss += __shfl_xor(ss, 2); ss += __shfl_xor(ss, 4);
            const float inv = 1.0f / fmaxf(sqrtf(ss), 1e-12f);
#pragma unroll
            for (int j = 0; j < 8; ++j) v[j] *= inv;
            store8(WSP(bf16, WS_KK) + (size_t)t * CW + 8 * lane, v); }
        if (lane < 32) { shift8(Zs, t, hp, 1536 + 8 * lane, mu, v);
#pragma unroll
            for (int j = 0; j < 8; ++j) { if (lane < 8) v[j] = tanhf(v[j]); else if (lane >= 16) v[j] = sigmoidf_(v[j]); }
            store8(WSP(bf16, WS_LIN) + (size_t)t * 256 + 8 * lane, v); }
    }
}

__device__ __forceinline__ void attn_phase(Frame& F) {
    LAS unsigned char* Ksm = F.lds + RING_OFF; LAS unsigned char* Vsm = Ksm + 32768;
    const int lane = F.lane, wave = F.wave, tid = F.tid, r = lane & 31, h = lane >> 5;
    const bf16* Qb = WSP(bf16, WS_QB); const bf16* Kb = WSP(bf16, WS_KB); const bf16* Vb = WSP(bf16, WS_VB); bf16* Yatt = WSP(bf16, WS_YATT);
    for (int U = F.vcu; U < BATCH * 2 * 16; U += F.G) {
        const int n = U & 15, kvh = (U >> 4) & 1, b = U >> 5; const int tb = b * SEQ + n * 128;
#pragma unroll
        for (int i = 0; i < 4; ++i) { const int q = tid + 512 * i, row = q >> 3, c16 = q & 7; const int tok = tb - 128 + row;
            v4u kv = (v4u){0u, 0u, 0u, 0u}, vv = (v4u){0u, 0u, 0u, 0u};
            if (n > 0 || row >= 128) { kv = *(const GAS v4u*)(Kb + (size_t)tok * 128 + kvh * 64 + c16 * 8); vv = *(const GAS v4u*)(Vb + (size_t)tok * 128 + kvh * 64 + c16 * 8); }
            *(LAS v4u*)(Ksm + row * 128 + ((c16 ^ ((row >> 1) & 7)) << 4)) = kv;
            *(LAS v4u*)(Vsm + row * 128 + ((c16 ^ (((row >> 1) & 1) << 2)) << 4)) = vv; }
        __syncthreads();
        const int hq = kvh * 4 + (wave >> 1); const float sink2 = INF(16)[hq] * LOG2E;
#pragma unroll 1
        for (int qs = 0; qs < 2; ++qs) {
            const int qo = (wave & 1) * 64 + 32 * qs, q0 = tb + qo, ks0 = qo >> 5;
            bf16x8 qf[4];
#pragma unroll
            for (int s = 0; s < 4; ++s) qf[s] = *(const GAS bf16x8*)(Qb + (size_t)(q0 + r) * CW + hq * 64 + 16 * s + 8 * h);
            f32x16 st[5];
#pragma unroll
            for (int t5 = 0; t5 < 5; ++t5) { const int key = 32 * (ks0 + t5) + r; f32x16 a;
#pragma unroll
                for (int i = 0; i < 16; ++i) a[i] = 0.f;
#pragma unroll
                for (int s = 0; s < 4; ++s) { const bf16x8 kf = *(const LAS bf16x8*)(Ksm + key * 128 + (((2 * s + h) ^ ((key >> 1) & 7)) << 4));
                    a = __builtin_amdgcn_mfma_f32_32x32x16_bf16(kf, qf[s], a, 0, 0, 0); }
                st[t5] = a; }
            float mx = sink2;
#pragma unroll
            for (int t5 = 0; t5 < 5; ++t5) { const bool dead = (n == 0) && (ks0 + t5 < 4);
#pragma unroll
                for (int i = 0; i < 16; ++i) { const int krow = (i & 3) + 8 * (i >> 2) + 4 * h; bool vis = !dead;
                    if (t5 == 0) vis = vis && (krow >= r + 1); if (t5 == 4) vis = vis && (krow <= r);
                    const float v = vis ? st[t5][i] : -INFINITY; st[t5][i] = v; mx = fmaxf(mx, v); } }
            mx = fmaxf(mx, __shfl_xor(mx, 32));
            float l = 0.f;
#pragma unroll
            for (int t5 = 0; t5 < 5; ++t5)
#pragma unroll
                for (int i = 0; i < 16; ++i) { const float p = __builtin_amdgcn_exp2f(st[t5][i] - mx); st[t5][i] = p; l += p; }
            l += __shfl_xor(l, 32); l += __builtin_amdgcn_exp2f(sink2 - mx);
            f32x16 o[2];
#pragma unroll
            for (int i = 0; i < 16; ++i) { o[0][i] = 0.f; o[1][i] = 0.f; }
            const int li = lane & 15, qrow = li >> 2, p4 = li & 3;
#pragma unroll
            for (int t5 = 0; t5 < 5; ++t5)
#pragma unroll
                for (int s2 = 0; s2 < 2; ++s2) {
                    bf16x8 pf; { const unsigned w0 = cvt_pk(st[t5][8 * s2 + 0], st[t5][8 * s2 + 1]), w1 = cvt_pk(st[t5][8 * s2 + 2], st[t5][8 * s2 + 3]), w2 = cvt_pk(st[t5][8 * s2 + 4], st[t5][8 * s2 + 5]), w3 = cvt_pk(st[t5][8 * s2 + 6], st[t5][8 * s2 + 7]);
                        const v4u w = (v4u){w0, w1, w2, w3}; pf = __builtin_bit_cast(bf16x8, w); }
                    const int row0 = 32 * (ks0 + t5) + 16 * s2 + 4 * h + qrow;
#pragma unroll
                    for (int dt = 0; dt < 2; ++dt) { const int col = dt * 32 + 16 * ((lane >> 4) & 1) + 4 * p4;
                        const int off0 = row0 * 128 + ((((col >> 3) ^ (((row0 >> 1) & 1) << 2)) << 4) | (((col >> 2) & 1) << 3));
                        const s16x4 lo = __builtin_bit_cast(s16x4, __builtin_amdgcn_ds_read_tr16_b64_v4i16((LAS s16x4*)(Vsm + off0)));
                        const s16x4 hi = __builtin_bit_cast(s16x4, __builtin_amdgcn_ds_read_tr16_b64_v4i16((LAS s16x4*)(Vsm + off0 + 8 * 128)));
                        const bf16x8 vf = (bf16x8){lo[0], lo[1], lo[2], lo[3], hi[0], hi[1], hi[2], hi[3]};
                        o[dt] = __builtin_amdgcn_mfma_f32_32x32x16_bf16(vf, pf, o[dt], 0, 0, 0); } }
            const float inv = 1.0f / l;
#pragma unroll
            for (int dt = 0; dt < 2; ++dt)
#pragma unroll
                for (int g = 0; g < 4; ++g) { const f32x4 v = (f32x4){o[dt][4 * g], o[dt][4 * g + 1], o[dt][4 * g + 2], o[dt][4 * g + 3]} * inv;
                    *(u32x2*)(Yatt + (size_t)(q0 + r) * CW + hq * 64 + dt * 32 + 8 * g + 4 * h) = pack4(v); }
        }
        __syncthreads();
    }
}

template <int CTRL> __device__ __forceinline__ float dpp_f(float x) { return __builtin_bit_cast(float, __builtin_amdgcn_update_dpp(0, __builtin_bit_cast(int, x), CTRL, 0xF, 0xF, true)); }
__device__ __forceinline__ float red16(float x) { x += dpp_f<0xB1>(x); x += dpp_f<0x4E>(x); x += dpp_f<0x141>(x); x += dpp_f<0x140>(x); return x; }
constexpr int SC_CH = 32, SC_NCH = SEQ / SC_CH;
__device__ __forceinline__ void scan_phase(Frame& F) {
    LAS float* buf0 = (LAS float*)(F.lds + RING_OFF); LAS float* buf1 = buf0 + 6 * SC_CH * 64; LAS float* ybuf = buf1 + 6 * SC_CH * 64;
    const int tid = F.tid, lane = F.lane, wave = F.wave, kg = tid & 15, rg = tid >> 4;
    const bf16* Rb = WSP(bf16, WS_R); const bf16* Krb = WSP(bf16, WS_KR); const bf16* Vrb = WSP(bf16, WS_VR); const bf16* KKb = WSP(bf16, WS_KK); const bf16* Bbb = WSP(bf16, WS_BB);
    const float* DEC = WSP(float, WS_DEC); const bf16* Gg = WSP(bf16, WS_GG); bf16* Yrw = WSP(bf16, WS_YRW);
    for (int U = F.vcu; U < BATCH * 8; U += F.G) {
        const int b = U >> 3, hh = U & 7, cb = hh * 64; const size_t tok0 = (size_t)b * SEQ;
        float S0[4] = {0.f, 0.f, 0.f, 0.f}, S1[4] = {0.f, 0.f, 0.f, 0.f};
        v4u pre[3]; f32x4 pred;
#define SC_ISSUE(c) do { _Pragma("unroll") for (int i = 0; i < 3; ++i) { const int q = tid + 512 * i; if (q < 1280) { const int a = q >> 8, rem = q & 255, tk = rem >> 3, c8 = rem & 7; \
            const bf16* src = (a == 0 ? Rb : a == 1 ? Krb : a == 2 ? Vrb : a == 3 ? KKb : Bbb) + (tok0 + (size_t)(c) * SC_CH + tk) * CW + cb + 8 * c8; pre[i] = *(const GAS v4u*)src; } } \
            pred = *(const GAS f32x4*)(DEC + (tok0 + (size_t)(c) * SC_CH + (tid >> 4)) * CW + cb + 4 * (tid & 15)); } while (0)
#define SC_WRITE(dst) do { _Pragma("unroll") for (int i = 0; i < 3; ++i) { const int q = tid + 512 * i; if (q < 1280) { const int a = q >> 8, rem = q & 255, tk = rem >> 3, c8 = rem & 7; \
            LAS float* d = (dst) + a * (SC_CH * 64) + tk * 64 + 8 * c8; const v4u w = pre[i]; \
            *(LAS f32x4*)d = (f32x4){bflo(w.x), bfhi(w.x), bflo(w.y), bfhi(w.y)}; *(LAS f32x4*)(d + 4) = (f32x4){bflo(w.z), bfhi(w.z), bflo(w.w), bfhi(w.w)}; } } \
            *(LAS f32x4*)((dst) + 5 * (SC_CH * 64) + (tid >> 4) * 64 + 4 * (tid & 15)) = pred; } while (0)
        SC_ISSUE(0); SC_WRITE(buf0);
        __syncthreads();
#pragma unroll 1
        for (int c = 0; c < SC_NCH; ++c) {
            LAS float* cur = (c & 1) ? buf1 : buf0; LAS float* nxt = (c & 1) ? buf0 : buf1;
            if (c + 1 < SC_NCH) SC_ISSUE(c + 1);
#pragma unroll 2
            for (int t = 0; t < SC_CH; ++t) {
                const f32x4 r4 = *(const LAS f32x4*)(cur + 0 * (SC_CH * 64) + t * 64 + 4 * kg), k4 = *(const LAS f32x4*)(cur + 1 * (SC_CH * 64) + t * 64 + 4 * kg);
                const f32x4 kk4 = *(const LAS f32x4*)(cur + 3 * (SC_CH * 64) + t * 64 + 4 * kg), b4 = *(const LAS f32x4*)(cur + 4 * (SC_CH * 64) + t * 64 + 4 * kg);
                const f32x4 w4 = *(const LAS f32x4*)(cur + 5 * (SC_CH * 64) + t * 64 + 4 * kg); const f32x2 v2 = *(const LAS f32x2*)(cur + 2 * (SC_CH * 64) + t * 64 + 2 * rg);
                float d0 = (S0[0] * kk4[0] + S0[1] * kk4[1]) + (S0[2] * kk4[2] + S0[3] * kk4[3]);
                float d1 = (S1[0] * kk4[0] + S1[1] * kk4[1]) + (S1[2] * kk4[2] + S1[3] * kk4[3]);
                d0 = red16(d0); d1 = red16(d1);
                float y0 = 0.f, y1 = 0.f;
#pragma unroll
                for (int i = 0; i < 4; ++i) { S0[i] = S0[i] * w4[i] + (v2[0] * k4[i] - d0 * b4[i]); S1[i] = S1[i] * w4[i] + (v2[1] * k4[i] - d1 * b4[i]); y0 += S0[i] * r4[i]; y1 += S1[i] * r4[i]; }
                y0 = red16(y0); y1 = red16(y1);
                if (kg == 0) *(LAS f32x2*)(ybuf + t * 64 + 2 * rg) = (f32x2){y0, y1};
            }
            __syncthreads();
#pragma unroll
            for (int j = 0; j < SC_CH / NWAVES; ++j) { const int t = wave * (SC_CH / NWAVES) + j; const size_t tok = tok0 + (size_t)c * SC_CH + t;
                const float y = ybuf[t * 64 + lane]; const float mean = wave_sum(y) * (1.0f / 64.0f); const float d = y - mean; const float var = wave_sum(d * d) * (1.0f / 64.0f);
                const float yn = d * (1.0f / sqrtf(var + GN_EPS)) * INF(14)[cb + lane] + INF(15)[cb + lane];
                const float rk = cur[0 * (SC_CH * 64) + t * 64 + lane] * cur[1 * (SC_CH * 64) + t * 64 + lane] * INF(13)[cb + lane];
                const float bonus = wave_sum(rk) * cur[2 * (SC_CH * 64) + t * 64 + lane];
                const float g = bf1(Gg[tok * CW + cb + lane]);
                const float o = (yn + bonus) * g; const unsigned ob = cvt_pk(o, o);
                Yrw[tok * CW + cb + lane] = (bf16)(ob & 0xffffu); }
            if (c + 1 < SC_NCH) SC_WRITE(nxt);
            __syncthreads();
        }
#undef SC_ISSUE
#undef SC_WRITE
    }
}

__device__ __forceinline__ void route_tile(Frame& F, int pm) {
    LAS unsigned* hist = (LAS unsigned*)(F.lds + RING_OFF);
    const int tid = F.tid;
    if (tid < 32) hist[tid] = 0u;
    __syncthreads();
    if (tid < 256) {
        const int t = pm * 256 + tid; const float* lg = WSP(float, WS_LOG) + (size_t)t * 64;
        const f32x4 g4 = *(const GAS f32x4*)lg;
        int gi = 0; float gm = g4[0];
        if (g4[1] > gm) { gm = g4[1]; gi = 1; } if (g4[2] > gm) { gm = g4[2]; gi = 2; } if (g4[3] > gm) { gm = g4[3]; gi = 3; }
        const float gden = (__expf(g4[0] - gm) + __expf(g4[1] - gm)) + (__expf(g4[2] - gm) + __expf(g4[3] - gm));
        const float gw = 1.0f / gden;
        const f32x4 e0 = *(const GAS f32x4*)(lg + 4 + gi * 8), e1 = *(const GAS f32x4*)(lg + 8 + gi * 8);
        float ev[8] = {e0[0], e0[1], e0[2], e0[3], e1[0], e1[1], e1[2], e1[3]};
        int i1 = 0; float m1 = ev[0];
#pragma unroll
        for (int j = 1; j < 8; ++j) if (ev[j] > m1) { m1 = ev[j]; i1 = j; }
        int i2 = -1; float m2 = -INFINITY;
#pragma unroll
        for (int j = 0; j < 8; ++j) if (j != i1 && ev[j] > m2) { m2 = ev[j]; i2 = j; }
        const float ex = __expf(m2 - m1); const float w1 = 1.0f / (1.0f + ex), w2 = ex * w1;
        const int x1 = gi * 8 + i1, x2 = gi * 8 + i2;
        const unsigned r1 = __hip_atomic_fetch_add(hist + x1, 1u, __ATOMIC_RELAXED, __HIP_MEMORY_SCOPE_WORKGROUP);
        const unsigned r2 = __hip_atomic_fetch_add(hist + x2, 1u, __ATOMIC_RELAXED, __HIP_MEMORY_SCOPE_WORKGROUP);
        WSP(int, WS_RT_E)[2 * t] = x1; WSP(int, WS_RT_E)[2 * t + 1] = x2;
        WSP(float, WS_RT_W)[2 * t] = gw * w1; WSP(float, WS_RT_W)[2 * t + 1] = gw * w2;
        WSP(int, WS_RT_RANK)[2 * t] = (int)r1; WSP(int, WS_RT_RANK)[2 * t + 1] = (int)r2;
    }
    __syncthreads();
    if (tid < 32) WSP(int, WS_TABLE)[pm * 32 + tid] = (int)hist[tid];
    __syncthreads();
}

__device__ __forceinline__ void gather_phase(Frame& F) {
    LAS int* tab = (LAS int*)(F.lds + RING_OFF);
    LAS int* pstart = tab + 256 * 32;
    LAS int* base = pstart + 64;
    const int tid = F.tid, lane = F.lane, wave = F.wave;
    for (int i = tid; i < 256 * 32; i += NWAVES * 64) tab[i] = WSP(int, WS_TABLE)[i];
    __syncthreads();
    if (tid < 32) { int s = 0; for (int pm = 0; pm < 256; ++pm) s += tab[pm * 32 + tid]; base[tid] = (s + 255) & ~255; }
    __syncthreads();
    if (tid == 0) { int s = 0; for (int e = 0; e < NEXP; ++e) { pstart[e] = s; s += base[e]; } pstart[NEXP] = s; }
    __syncthreads();
    if (F.vcu == 0) {
        int* meta = WSP(int, WS_META); const int nrt = pstart[NEXP] >> 8;
        if (tid == 0) meta[0] = nrt;
        if (tid < 33) meta[1 + tid] = pstart[tid];
        for (int rt = tid; rt < nrt; rt += NWAVES * 64) { int e = 0;
            for (int j = 1; j < NEXP; ++j) if ((rt << 8) >= pstart[j]) e = j;
            meta[64 + rt] = e; }
    }
    for (int pm = F.vcu; pm < T / 256; pm += F.G) {
        __syncthreads();
        if (tid < 32) { int s = pstart[tid]; for (int q = 0; q < pm; ++q) s += tab[q * 32 + tid]; base[tid] = s; }
        __syncthreads();
        { const int t = pm * 256 + (tid >> 1), k = tid & 1; const int e = WSP(int, WS_RT_E)[2 * t + k], rk = WSP(int, WS_RT_RANK)[2 * t + k];
            const int pos = base[e] + rk; WSP(int, WS_RT_POS)[2 * t + k] = pos; WSP(float, WS_ROWSCALE)[pos] = WSP(float, WS_RSTD2)[t]; }
        for (int a = wave * 64; a < wave * 64 + 64; ++a) { const int t = pm * 256 + (a >> 1), k = a & 1; const int e = WSP(int, WS_RT_E)[2 * t + k], rk = WSP(int, WS_RT_RANK)[2 * t + k];
            const int pos = base[e] + rk;
            const GAS v4u* s = (const GAS v4u*)(WSP(bf16, WS_XB) + (size_t)t * DM) + lane; GAS v4u* d = (GAS v4u*)(WSP(bf16, WS_XS) + (size_t)pos * DM) + lane;
            const v4u a0 = s[0], a1 = s[64]; d[0] = a0; d[64] = a1; }
    }
}

__device__ __forceinline__ void combine_phase(Frame& F) {
    const int gw = F.vcu * NWAVES + F.wave, NGW = F.G * NWAVES, lane = F.lane;
    for (int t = gw; t < T; t += NGW) {
        const int p0 = WSP(int, WS_RT_POS)[2 * t], p1 = WSP(int, WS_RT_POS)[2 * t + 1]; const float w0 = WSP(float, WS_RT_W)[2 * t], w1 = WSP(float, WS_RT_W)[2 * t + 1];
        GAS f32x4* xr = (GAS f32x4*)(WSP(float, WS_X1) + (size_t)t * DM) + lane;
        const GAS u32x2* y0 = (const GAS u32x2*)(WSP(bf16, WS_Y) + (size_t)p0 * DM) + lane; const GAS u32x2* y1 = (const GAS u32x2*)(WSP(bf16, WS_Y) + (size_t)p1 * DM) + lane;
        GAS u32x2* xb = (GAS u32x2*)(WSP(bf16, WS_XB) + (size_t)t * DM) + lane;
        float s = 0.f;
#pragma unroll
        for (int j = 0; j < 4; ++j) { const f32x4 a = xr[64 * j], b0 = unpack4(y0[64 * j]), b1 = unpack4(y1[64 * j]); const f32x4 o = a + (b0 * w0 + b1 * w1);
            xr[64 * j] = o; xb[64 * j] = pack4(o); s += (o[0] * o[0] + o[1] * o[1]) + (o[2] * o[2] + o[3] * o[3]); }
        s = wave_sum(s);
        if (lane == 0) WSP(float, WS_RSTD3)[t] = 1.0f / sqrtf(s * (1.0f / DM) + NORM_EPS);
    }
}

__device__ __forceinline__ void final_phase(Frame& F) {
    const int gw = F.vcu * NWAVES + F.wave, NGW = F.G * NWAVES, lane = F.lane;
    const GAS f32x4* gn = (const GAS f32x4*)INF(31) + lane; f32x4 g[4];
#pragma unroll
    for (int j = 0; j < 4; ++j) g[j] = gn[64 * j];
    for (int t = gw; t < T; t += NGW) {
        const float* sp = WSP(float, WS_SSQ4) + (size_t)t * 16; float s = 0.f;
#pragma unroll
        for (int j = 0; j < 16; ++j) s += sp[j];
        const float rs = 1.0f / sqrtf(s * (1.0f / DM) + NORM_EPS);
        GAS f32x4* o = (GAS f32x4*)(F.out + (size_t)t * DM) + lane;
#pragma unroll
        for (int j = 0; j < 4; ++j) o[64 * j] = o[64 * j] * rs * g[j];
    }
}

constexpr int NPH = 14;
struct Args { const void* in[32]; float* out; unsigned char* ws; int ph_lo, ph_hi; };
__global__ void __launch_bounds__(NWAVES * 64, 2) fwd_kernel(Args args) {
    extern __shared__ __attribute__((aligned(16))) unsigned char lds[];
    Frame F;
    F.lds = (LAS unsigned char*)lds;
    F.MISC = (volatile LAS unsigned*)(F.lds + MISC_OFF);
    F.tid = threadIdx.x; F.lane = F.tid & 63; F.wave = __builtin_amdgcn_readfirstlane(F.tid >> 6);
    F.G = gridDim.x; { const int bx = blockIdx.x; F.vcu = (F.G % 8 == 0) ? (bx % 8) * (F.G / 8) + bx / 8 : bx; }
    F.ws = args.ws; F.out = args.out; F.in = args.in;
    F.ctl = (gu32*)(args.ws + WS_CTL);
    for (int u = F.tid; u < (LDS_BYTES - LDSCTL_OFF) / 4; u += NWAVES * 64) ((LAS unsigned*)(F.lds + LDSCTL_OFF))[u] = 0u;
    __syncthreads();
#if MK_SINGLE
    XcdBarrier bar = xcd_barrier_post((unsigned*)(F.ctl + CW_BAR), F.MISC + 8);
#define GRID_BAR() xcd_barrier(bar)
#else
#define GRID_BAR() do { } while (0)
#endif
    const int lo = args.ph_lo, hi = args.ph_hi;
#ifndef PHMASK
#define PHMASK 0xFFFF
#endif
#define IN(k) (((PHMASK >> (k)) & 1) && lo <= (k) && (k) < hi)
#define SEAM(k) do { if (IN(k) && IN((k) + 1)) GRID_BAR(); } while (0)
    LAS unsigned char* ring = F.lds + RING_OFF;
    const int bx = (int)blockIdx.x;

    if (IN(0)) { p0_prologue(F); } SEAM(0);

    if (IN(1)) {
        pg8::Gemm g{WSP(bf16, WS_XB), WSP(bf16, WS_WIN), T, NIN, DM}; pg8::StaticOrder S; S.init(T, NIN, F.G, bx);
        EpiZ E{WSP(float, WS_RSTD1), WSP(float, WS_ROPE), WSP(bf16, WS_QB), WSP(bf16, WS_KB), WSP(bf16, WS_VB), WSP(bf16, WS_ZS), (bf16*)F.out};
        pg8::gemm_phase<EpiZ, pg8::StaticOrder, true, true>(ring, g, S, E);
    } SEAM(1);

    if (IN(2)) { rp1_phase(F); } SEAM(2);

    if (IN(3)) {
        { pg8::Gemm g{WSP(bf16, WS_LIN), WSP(bf16, WS_WL), T, 1536, 256}; pg8::StaticOrder S; S.init(T, 1536, F.G, bx);
          EpiLora E{INF(6), INF(8), INF(12), WSP(float, WS_DEC), WSP(bf16, WS_KR), WSP(bf16, WS_KK), WSP(bf16, WS_BB), WSP(bf16, WS_GG)};
          pg8::gemm_phase<EpiLora, pg8::StaticOrder, true, true>(ring, g, S, E); }
        __syncthreads();
        attn_phase(F);
    } SEAM(3);

    if (IN(4)) { scan_phase(F); } SEAM(4);

    if (IN(5)) {
        { pg8::Gemm g{WSP(bf16, WS_YATT), WSP(bf16, WS_WBA), T, DM, CW}; pg8::StaticOrder S; S.init(T, DM, F.G, bx);
          EpiMerge<0> E{(const bf16*)F.out, WSP(bf16, WS_MRG)}; pg8::gemm_phase<EpiMerge<0>, pg8::StaticOrder, true, true>(ring, g, S, E); }
        { pg8::Gemm g{WSP(bf16, WS_YRW), WSP(bf16, WS_WBB), T, DM, CW}; pg8::StaticOrder S; S.init(T, DM, F.G, bx);
          EpiMerge<1> E{(const bf16*)F.out, WSP(bf16, WS_MRG)}; pg8::gemm_phase<EpiMerge<1>, pg8::StaticOrder, true, true>(ring, g, S, E); }
    } SEAM(5);

    if (IN(6)) {
        pg8::Gemm g{WSP(bf16, WS_MRG), WSP(bf16, WS_WOUT), T, DM, DM}; pg8::StaticOrder S; S.init(T, DM, F.G, bx);
        EpiOut E{INF(0), WSP(float, WS_X1), WSP(bf16, WS_XB), WSP(float, WS_SSQ2)};
        pg8::gemm_phase<EpiOut, pg8::StaticOrder, true, true>(ring, g, S, E);
    } SEAM(6);

    if (IN(7)) {
        pg8::Gemm g{WSP(bf16, WS_XB), WSP(bf16, WS_WR), T, 256, DM}; pg8::StaticOrder S; S.init(T, 256, F.G, bx);
        EpiRouter E{WSP(float, WS_SSQ2), INF(22), INF(24), WSP(float, WS_RSTD2), WSP(float, WS_LOG)};
        pg8::gemm_phase<EpiRouter, pg8::StaticOrder, true, true>(ring, g, S, E);
        __syncthreads();
        pg8::Unit u; for (int i = 0; S.next(i, u); ++i) route_tile(F, u.pm);
    } SEAM(7);

    if (IN(8)) { gather_phase(F); } SEAM(8);

    if (IN(9)) {
        const int nrt = WSP(int, WS_META)[0]; LAS int* te = (LAS int*)(F.lds + TILEE_OFF);
        for (int i = F.tid; i < nrt; i += NWAVES * 64) te[i] = WSP(int, WS_META)[64 + i];
        __syncthreads();
        pg8::Gemm g{WSP(bf16, WS_XS), WSP(bf16, WS_WGU), 0, 0, DM}; MoeOrder S{nrt * 4, F.G, F.vcu, te};
        EpiGU E{WSP(float, WS_ROWSCALE), WSP(bf16, WS_HID)};
        pg8::gemm_phase<EpiGU, MoeOrder, true, true>(ring, g, S, E);
    } SEAM(9);

    if (IN(10)) {
        const int nrt = WSP(int, WS_META)[0]; LAS int* te = (LAS int*)(F.lds + TILEE_OFF);
        for (int i = F.tid; i < nrt; i += NWAVES * 64) te[i] = WSP(int, WS_META)[64 + i];
        __syncthreads();
        pg8::Gemm g{WSP(bf16, WS_HID), WSP(bf16, WS_WD), 0, 0, DEXP}; MoeOrder S{nrt * 4, F.G, F.vcu, te};
        EpiStore E{WSP(bf16, WS_Y), DM};
        pg8::gemm_phase<EpiStore, MoeOrder, true, true>(ring, g, S, E);
    } SEAM(10);

    if (IN(11)) { combine_phase(F); } SEAM(11);

    if (IN(12)) {
        { pg8::Gemm g{WSP(bf16, WS_PB), WSP(bf16, WS_WPP), T, DM, PLE}; pg8::StaticOrder S; S.init(T, DM, F.G, bx);
          EpiStore E{WSP(bf16, WS_PP), DM}; pg8::gemm_phase<EpiStore, pg8::StaticOrder, true, true>(ring, g, S, E); }
        { pg8::Gemm g{WSP(bf16, WS_XB), WSP(bf16, WS_WPG), T, DM, DM}; pg8::StaticOrder S; S.init(T, DM, F.G, bx);
          EpiPle E{WSP(float, WS_RSTD3), WSP(float, WS_X1), WSP(bf16, WS_PP), F.out, WSP(float, WS_SSQ4)};
          pg8::gemm_phase<EpiPle, pg8::StaticOrder, true, true>(ring, g, S, E); }
    } SEAM(12);

    if (IN(13)) { final_phase(F); }
#undef IN
#undef SEAM
}

extern "C" void kernel_launch(void* const* d_in, const int* in_sizes, int n_in, void* d_out, int out_size, void* d_ws, size_t ws_size, hipStream_t stream) {
    static int grid = 0;
    if (grid == 0) {
        if (n_in != 32 || in_sizes[0] != T * DM || out_size != T * DM || ws_size < WS_END) {
            fprintf(stderr, "kernel_launch: unexpected shapes (n_in %d, in0 %d, out %d, ws %zu); nothing launched\n", n_in, n_in > 0 ? in_sizes[0] : -1, out_size, ws_size); grid = -1; return; }
        int dev = 0, cus = 0, per_cu = 0;
        if (hipGetDevice(&dev) != hipSuccess || hipDeviceGetAttribute(&cus, hipDeviceAttributeMultiprocessorCount, dev) != hipSuccess) { grid = -1; return; }
        if (hipFuncSetAttribute((const void*)fwd_kernel, hipFuncAttributeMaxDynamicSharedMemorySize, LDS_BYTES) != hipSuccess) { fprintf(stderr, "kernel_launch: hipFuncSetAttribute failed\n"); grid = -1; return; }
        if (hipOccupancyMaxActiveBlocksPerMultiprocessor(&per_cu, (const void*)fwd_kernel, NWAVES * 64, LDS_BYTES) != hipSuccess || per_cu < 1) { fprintf(stderr, "kernel_launch: occupancy query says %d blocks per CU\n", per_cu); per_cu = 1; }
        (void)hipGetLastError();
        grid = cus;
    }
    if (grid < 0) return;
    Args a{};
    for (int i = 0; i < 32; ++i) a.in[i] = d_in[i];
    a.out = (float*)d_out; a.ws = (unsigned char*)d_ws;
#if MK_SINGLE
    (void)hipMemsetAsync((char*)d_ws + WS_CTL, 0, CTL_ZERO_BYTES, stream);
    a.ph_lo = 0; a.ph_hi = NPH;
    void* kargs[] = {&a};
    hipError_t e = hipLaunchCooperativeKernel((const void*)fwd_kernel, dim3(grid), dim3(NWAVES * 64), kargs, LDS_BYTES, stream);
    if (e != hipSuccess) fprintf(stderr, "kernel_launch: cooperative launch failed: %s (grid %d)\n", hipGetErrorString(e), grid);
#else
    for (int ph = 0; ph < NPH; ++ph) {
        a.ph_lo = ph; a.ph_hi = ph + 1;
        hipLaunchKernelGGL(fwd_kernel, dim3(grid), dim3(NWAVES * 64), LDS_BYTES, stream, a);
    }
#endif
}
```

```cpp
#include <hip/hip_runtime.h>
#include <hip/hip_bf16.h>
#include <cstdio>
#include <cstdint>
#include <cmath>

#ifndef MK_SINGLE
#define MK_SINGLE 1
#endif

namespace pg8 {
#define PG8_LAS __attribute__((address_space(3)))
typedef unsigned short bf16_t;
typedef short bf16x8 __attribute__((ext_vector_type(8)));
typedef float f32x4 __attribute__((ext_vector_type(4)));
typedef unsigned u32x4 __attribute__((ext_vector_type(4)));
constexpr int BM = 256, BK = 64, HALF = 128, HTB = HALF * BK * 2  , STAGE_BYTES = 8 * HTB, NXCD = 8, WGM = 8;

__host__ __device__ __forceinline__ int lds_byte(int r, int c) { const int st = (r >> 4) * 2 + (c >> 5), rr = r & 15, cc = c & 31, ob = rr * 64 + cc * 2; return st * 1024 + (ob ^ (((ob >> 9) & 1) << 5)); }
__host__ __device__ __forceinline__ void stage_rc(int b, int& R, int& C) { const int st = b / 1024, sb = b % 1024, swz = sb ^ (((sb >> 9) & 1) << 5); R = (st >> 1) * 16 + swz / 64; C = (st & 1) * 32 + (swz % 64) / 2; }
__host__ __device__ __forceinline__ int perm32(int rho) { const int n = rho >> 4, i = rho & 15; return 8 * (i >> 2) + 4 * n + (i & 3); }

struct Unit { int pm, pn, pb; };
struct Gemm { const bf16_t* A; const bf16_t* Bt; int M, N, K; };

struct StaticOrder {
    static constexpr bool GATHER = false; __device__ __forceinline__ const int* rowtok() const { return nullptr; }
    int nM, nN, nwg, G, c;
    __host__ __device__ __forceinline__ void init(int M, int N, int G_, int c_) { nM = M / BM; nN = N / BM; nwg = nM * nN; G = G_; c = c_; }
    __host__ __device__ __forceinline__ bool next(int i, Unit& u) const {
        const long L = (long)i * G + c; if (L >= nwg) return false;
        int wgid = (int)L; { const int q = nwg / NXCD, r = nwg % NXCD, xcd = wgid % NXCD, off = wgid / NXCD; wgid = (xcd < r ? xcd * (q + 1) : r * (q + 1) + (xcd - r) * q) + off; }
        const int nig = WGM * nN, gid = wgid / nig, fm = gid * WGM, gsz = (nM - fm) < WGM ? (nM - fm) : WGM;
        u.pm = fm + ((wgid % nig) % gsz); u.pn = (wgid % nig) / gsz; u.pb = u.pn; return true;
    }
    __device__ __forceinline__ void a_ready(const Unit&) const {}
    __device__ __forceinline__ void done(const Unit&) const {}
};

template <class Epi, class Sched, bool ALIGN_EPI = false, bool SP2 = false>
__device__ __forceinline__ void gemm_phase(PG8_LAS unsigned char* lds, const Gemm g, const Sched& S, const Epi& E, const int wave_id) {
    int tid_; asm volatile("v_mbcnt_lo_u32_b32 %0, -1, 0\n\tv_mbcnt_hi_u32_b32 %0, -1, %0" : "=v"(tid_)); tid_ += wave_id * 64;
    const int tid = tid_, wid = __builtin_amdgcn_readfirstlane(tid >> 6), lane = tid & 63, wr = wid >> 2, wc = wid & 3, fr = lane & 15, fq = lane >> 4;
    const int K = g.K, nt = K / BK;
    unsigned voffA[2], voffB[2];
#pragma unroll
    for (int i = 0; i < 2; ++i) { int R, C; stage_rc(tid * 16 + i * 8192, R, C); const int Rb = Epi::PERM ? ((R & ~31) + perm32(R & 31)) : R;
        voffA[i] = (unsigned)(R * K + C) * 2u; voffB[i] = (unsigned)(Rb * K + C) * 2u; }
    const size_t kstep = (size_t)(BK * 2);
    const size_t hstep = (size_t)HALF * K * 2;
    const size_t tstep = 2 * hstep;
    const unsigned ldsw = (unsigned)wid * 1024u;
    const int aoff = lds_byte(wr * 64 + fr, fq * 8), boff = lds_byte(wc * 32 + fr, fq * 8);
#define PG8_SA(b, h) (((b) * 2 + (h)) * HTB)
#define PG8_SB(b, h) ((4 + (b) * 2 + (h)) * HTB)
#define PG8_STAGE(bufoff, gbase, voff) do { _Pragma("unroll") for (int _i = 0; _i < 2; ++_i) \
        __builtin_amdgcn_global_load_lds((const unsigned*)((const char*)(gbase) + (voff)[_i]), (PG8_LAS unsigned*)(lds + (bufoff) + ldsw + _i * 8192), 16, 0, 0); } while (0)
#define PG8_STAGE_A(bufoff, gptr, h, VG) do { if constexpr (Sched::GATHER) { PG8_STAGE(bufoff, gptr, VG[h]); } else { PG8_STAGE(bufoff, (gptr) + (h) * hstep, voffA); } } while (0)
#define PG8_LDA(dst, b, h) do { _Pragma("unroll") for (int m = 0; m < 4; ++m) _Pragma("unroll") for (int k = 0; k < 2; ++k) dst[m][k] = *(const PG8_LAS bf16x8*)(lds + PG8_SA(b, h) + aoff + m * 2048 + k * 1024); } while (0)
#define PG8_LDB(dst, b, h) do { _Pragma("unroll") for (int n = 0; n < 2; ++n) _Pragma("unroll") for (int k = 0; k < 2; ++k) dst[n][k] = *(const PG8_LAS bf16x8*)(lds + PG8_SB(b, h) + boff + n * 2048 + k * 1024); } while (0)
#define PG8_MMA(ai, bj, At, Bt) do { __builtin_amdgcn_s_setprio(1); _Pragma("unroll") for (int m = 0; m < 4; ++m) _Pragma("unroll") for (int n = 0; n < 2; ++n) _Pragma("unroll") for (int k = 0; k < 2; ++k) \
        acc[ai][bj][m][n] = __builtin_amdgcn_mfma_f32_16x16x32_bf16(Bt[n][k], At[m][k], acc[ai][bj][m][n], 0, 0, 0); __builtin_amdgcn_s_setprio(0); } while (0)
#define PG8_WAIT_V(n) asm volatile("s_waitcnt vmcnt(" #n ")" ::: "memory")
#define PG8_WAIT_L(n) asm volatile("s_waitcnt lgkmcnt(" #n ")" ::: "memory")
#define PG8_BAR __builtin_amdgcn_s_barrier()
#define PG8_SCHED __builtin_amdgcn_sched_barrier(0)
    Unit cur, nxt; int ui = 0;
    if (!S.next(0, cur)) return;
    f32x4 acc[2][2][4][2];
#pragma unroll
    for (int a = 0; a < 2; ++a)
#pragma unroll
        for (int b = 0; b < 2; ++b)
#pragma unroll
            for (int m = 0; m < 4; ++m)
#pragma unroll
                for (int n = 0; n < 2; ++n) acc[a][b][m][n] = (f32x4){0.f, 0.f, 0.f, 0.f};
    bf16x8 At[4][2], B0[2][2], B1[2][2];
    unsigned vc[2][2], vn[2][2]; int RA[2], CA[2];
#pragma unroll
    for (int i = 0; i < 2; ++i) { stage_rc(tid * 16 + i * 8192, RA[i], CA[i]); }
    PG8_LAS int* tokl = (PG8_LAS int*)(lds + STAGE_BYTES + 4096);
    if constexpr (Sched::GATHER) {
#pragma unroll
        for (int h = 0; h < 2; ++h)
#pragma unroll
            for (int i = 0; i < 2; ++i) vc[h][i] = (unsigned)S.rowtok()[cur.pm * BM + h * HALF + RA[i]] * (unsigned)(K * 2) + (unsigned)(CA[i] * 2);
    } else {
#pragma unroll
        for (int h = 0; h < 2; ++h)
#pragma unroll
            for (int i = 0; i < 2; ++i) vc[h][i] = 0u;
    }
#pragma unroll
    for (int h = 0; h < 2; ++h)
#pragma unroll
        for (int i = 0; i < 2; ++i) vn[h][i] = vc[h][i];
    const char* cA = Sched::GATHER ? (const char*)g.A : (const char*)g.A + (size_t)cur.pm * tstep; const char* cB = (const char*)g.Bt + (size_t)cur.pb * tstep;
    S.a_ready(cur);
    if constexpr (SP2) {
        PG8_STAGE(PG8_SB(0, 0), cB, voffB); PG8_STAGE(PG8_SB(0, 1), cB + hstep, voffB); PG8_STAGE_A(PG8_SA(0, 0), cA, 0, vc); PG8_STAGE_A(PG8_SA(0, 1), cA, 1, vc);
        if (wr == 1) PG8_BAR;
        PG8_WAIT_V(2); PG8_BAR;
        PG8_STAGE(PG8_SB(1, 0), cB + kstep, voffB); PG8_STAGE_A(PG8_SA(1, 0), cA + kstep, 0, vc); PG8_STAGE(PG8_SB(1, 1), cB + hstep + kstep, voffB);
        PG8_WAIT_V(6); PG8_BAR;
    } else {
        PG8_STAGE(PG8_SB(0, 0), cB, voffB); PG8_STAGE_A(PG8_SA(0, 0), cA, 0, vc); PG8_STAGE(PG8_SB(0, 1), cB + hstep, voffB); PG8_STAGE_A(PG8_SA(0, 1), cA, 1, vc);
        if (wr == 1) PG8_BAR;
        PG8_WAIT_V(4); PG8_BAR;
        PG8_STAGE(PG8_SB(1, 0), cB + kstep, voffB); PG8_STAGE_A(PG8_SA(1, 0), cA + kstep, 0, vc); PG8_STAGE(PG8_SB(1, 1), cB + hstep + kstep, voffB);
        PG8_WAIT_V(6); PG8_BAR;
    }
    for (;;) {
        const bool has_next = S.next(ui + 1, nxt);
        const char* nA = Sched::GATHER ? cA : (has_next ? (const char*)g.A + (size_t)nxt.pm * tstep : cA); const char* nB = has_next ? (const char*)g.Bt + (size_t)nxt.pb * tstep : cB;
        if constexpr (Sched::GATHER) { if (has_next && wid == 0) __builtin_amdgcn_global_load_lds((const unsigned*)(S.rowtok() + nxt.pm * BM + lane * 4), (PG8_LAS unsigned*)(tokl + ((ui + 1) & 1) * 256), 16, 0, 0); }
        for (int t = 0; t < nt; t += 2) {
            if constexpr (Epi::MIDK_T > 0) { if (t == Epi::MIDK_T) E.mid(acc, cur, wr, wc, fr, fq); }
            const bool last = (t == nt - 2);
            if constexpr (Sched::GATHER) { if (last && has_next) {
#pragma unroll
                for (int h = 0; h < 2; ++h)
#pragma unroll
                    for (int i = 0; i < 2; ++i) vn[h][i] = (unsigned)tokl[((ui + 1) & 1) * 256 + h * HALF + RA[i]] * (unsigned)(K * 2) + (unsigned)(CA[i] * 2); } }
            unsigned v2[2][2];
#pragma unroll
            for (int h = 0; h < 2; ++h)
#pragma unroll
                for (int i = 0; i < 2; ++i) v2[h][i] = (Sched::GATHER && last) ? vn[h][i] : vc[h][i];
            const char* a1 = cA + (size_t)(t + 1) * kstep;
            const char* a2 = last ? nA : cA + (size_t)(t + 2) * kstep; const char* b2 = last ? nB : cB + (size_t)(t + 2) * kstep;
            const char* a3 = a2 + kstep; const char* b3 = b2 + kstep;
            if (last && has_next) S.a_ready(nxt);
            if constexpr (SP2) {
            PG8_LDB(B0, 0, 0); PG8_LDB(B1, 0, 1); PG8_SCHED; PG8_LDA(At, 0, 0); PG8_STAGE_A(PG8_SA(1, 1), a1, 1, vc);
            PG8_WAIT_V(8); PG8_WAIT_L(0); PG8_BAR; PG8_MMA(0, 0, At, B0); PG8_MMA(0, 1, At, B1); PG8_BAR; PG8_SCHED;
            PG8_LDA(At, 0, 1); PG8_STAGE(PG8_SB(0, 0), b2, voffB); PG8_STAGE(PG8_SB(0, 1), b2 + hstep, voffB); PG8_STAGE_A(PG8_SA(0, 0), a2, 0, v2);
            PG8_WAIT_V(8); PG8_WAIT_L(0); PG8_BAR; PG8_MMA(1, 0, At, B0); PG8_MMA(1, 1, At, B1); PG8_BAR; PG8_SCHED;
            PG8_LDB(B0, 1, 0); PG8_LDB(B1, 1, 1); PG8_SCHED; PG8_LDA(At, 1, 0); PG8_STAGE_A(PG8_SA(0, 1), a2, 1, v2);
            PG8_WAIT_V(8); PG8_WAIT_L(0); PG8_BAR; PG8_MMA(0, 0, At, B0); PG8_MMA(0, 1, At, B1); PG8_BAR; PG8_SCHED;
            PG8_LDA(At, 1, 1); PG8_STAGE(PG8_SB(1, 0), b3, voffB); PG8_STAGE(PG8_SB(1, 1), b3 + hstep, voffB); PG8_STAGE_A(PG8_SA(1, 0), a3, 0, v2);
            PG8_WAIT_V(8); PG8_WAIT_L(0); PG8_BAR; PG8_MMA(1, 0, At, B0); PG8_MMA(1, 1, At, B1); PG8_BAR; PG8_SCHED;
            } else {
            PG8_LDB(B0, 0, 0); PG8_SCHED; PG8_LDA(At, 0, 0); PG8_STAGE_A(PG8_SA(1, 1), a1, 1, vc);
            PG8_WAIT_L(8); PG8_BAR; PG8_WAIT_L(0); PG8_MMA(0, 0, At, B0); PG8_BAR; PG8_SCHED;
            PG8_LDB(B1, 0, 1); PG8_STAGE(PG8_SB(0, 0), b2, voffB);
            PG8_BAR; PG8_WAIT_L(0); PG8_MMA(0, 1, At, B1); PG8_BAR;
            PG8_LDA(At, 0, 1); PG8_STAGE_A(PG8_SA(0, 0), a2, 0, v2);
            PG8_BAR; PG8_WAIT_L(0); PG8_MMA(1, 0, At, B0); PG8_BAR; PG8_SCHED;
            PG8_STAGE(PG8_SB(0, 1), b2 + hstep, voffB);
            PG8_WAIT_V(6); PG8_BAR; PG8_MMA(1, 1, At, B1); PG8_BAR;
            PG8_LDB(B0, 1, 0); PG8_SCHED; PG8_LDA(At, 1, 0); PG8_STAGE_A(PG8_SA(0, 1), a2, 1, v2);
            PG8_WAIT_L(8); PG8_BAR; PG8_WAIT_L(0); PG8_MMA(0, 0, At, B0); PG8_BAR; PG8_SCHED;
            PG8_LDB(B1, 1, 1); PG8_STAGE(PG8_SB(1, 0), b3, voffB);
            PG8_BAR; PG8_WAIT_L(0); PG8_MMA(0, 1, At, B1); PG8_BAR;
            PG8_LDA(At, 1, 1); PG8_STAGE_A(PG8_SA(1, 0), a3, 0, v2);
            PG8_BAR; PG8_WAIT_L(0); PG8_MMA(1, 0, At, B0); PG8_BAR; PG8_SCHED;
            PG8_STAGE(PG8_SB(1, 1), b3 + hstep, voffB);
            PG8_WAIT_V(6); PG8_BAR; PG8_MMA(1, 1, At, B1); PG8_BAR;
            }
        }
        if constexpr (ALIGN_EPI) { if (wr == 0) PG8_BAR; }
        if constexpr (!Epi::AFTER_DRAIN) { E(acc, cur, wr, wc, fr, fq); S.done(cur); }
        if (!has_next) break;
#pragma unroll
        for (int a = 0; a < 2; ++a)
#pragma unroll
            for (int b = 0; b < 2; ++b)
#pragma unroll
                for (int m = 0; m < 4; ++m)
#pragma unroll
                    for (int n = 0; n < 2; ++n) acc[a][b][m][n] = (f32x4){0.f, 0.f, 0.f, 0.f};
        cur = nxt; cA = nA; cB = nB; ++ui;
        if constexpr (Sched::GATHER) {
#pragma unroll
            for (int h = 0; h < 2; ++h)
#pragma unroll
                for (int i = 0; i < 2; ++i) vc[h][i] = vn[h][i]; }
        if constexpr (ALIGN_EPI) { if (wr == 1) PG8_BAR; }
    }
    PG8_WAIT_V(0);
    if constexpr (!ALIGN_EPI) { if (wr == 0) PG8_BAR; }
    PG8_BAR;
    if constexpr (Epi::AFTER_DRAIN) { E.fused(acc, cur, wr, wc, fr, fq, lds, wid, lane); S.done(cur); }
#undef PG8_SA
#undef PG8_SB
#undef PG8_STAGE
#undef PG8_STAGE_A
#undef PG8_LDA
#undef PG8_LDB
#undef PG8_MMA
#undef PG8_WAIT_V
#undef PG8_WAIT_L
#undef PG8_BAR
#undef PG8_SCHED
}
}
#define GAS __attribute__((address_space(1)))
#define LAS __attribute__((address_space(3)))
typedef unsigned short bf16;
typedef unsigned v4u __attribute__((ext_vector_type(4)));
typedef float f32x4 __attribute__((ext_vector_type(4)));
typedef short bf16x8 __attribute__((ext_vector_type(8)));
typedef GAS unsigned gu32;
typedef GAS unsigned long long gu64;
#define RLX_AGENT __ATOMIC_RELAXED, __HIP_MEMORY_SCOPE_AGENT
#define LDS_WAIT() asm volatile("s_waitcnt lgkmcnt(0)" ::: "memory")
#define VM_WAIT() asm volatile("s_waitcnt vmcnt(0)" ::: "memory")
__device__ __forceinline__ unsigned long long rt() { return __builtin_amdgcn_s_memrealtime(); }
__device__ __forceinline__ unsigned f2bf(float f) { unsigned u = __builtin_bit_cast(unsigned, f); return (u + 0x7fffu + ((u >> 16) & 1u)) >> 16; }
__device__ __forceinline__ unsigned pk2(float lo, float hi) { return f2bf(lo) | (f2bf(hi) << 16); }

#define XB_TMO      128
#define XB_XCNT(j)  (256  + 64 * (j))
#define XB_XSUB(j)  (1280 + 64 * (j))
#define XB_XGEN(j)  (2304 + 64 * (j))
#define XB_TOP      3328
#define XB_TOPGEN   3392
#define XCD_BAR_WORDS 3456
#define XB_SPIN_CAP (1u << 18)

__device__ __forceinline__ unsigned xb_ld(unsigned* p)              { return __hip_atomic_load(p, __ATOMIC_RELAXED, __HIP_MEMORY_SCOPE_AGENT); }
__device__ __forceinline__ unsigned xb_add(unsigned* p, unsigned v) { return __hip_atomic_fetch_add(p, v, __ATOMIC_RELAXED, __HIP_MEMORY_SCOPE_AGENT); }
__device__ __forceinline__ unsigned xb_xcc_id() { return (unsigned)__builtin_amdgcn_s_getreg((3 << 11) | 20) & 0xFu; }
#define XB_SPIN(cond, bar) do { unsigned _sp = 0; while (cond) { __builtin_amdgcn_s_sleep(1); \
    if ((++_sp & 255u) == 0u) { if (xb_ld(&(bar)[XB_TMO])) break; if (_sp > XB_SPIN_CAP) { atomicAdd(&(bar)[XB_TMO], 1u); break; } } } } while (0)

struct XcdBarrier {
    unsigned* bar; unsigned x;
    volatile LAS unsigned* st;
};

__device__ __forceinline__ XcdBarrier xcd_barrier_post(unsigned* bar, volatile LAS unsigned* st) {
    XcdBarrier b; b.bar = bar; b.x = xb_xcc_id(); b.st = st;
    if (threadIdx.x == 0) (void)xb_add(&bar[XB_XCNT(b.x)], 1u);
    return b;
}
__device__ __forceinline__ void xcd_barrier_complete(unsigned* bar, unsigned x, unsigned& nloc, unsigned& nx) {
    const unsigned G = gridDim.x * gridDim.y * gridDim.z;
    unsigned sum, cnt, mine, sp = 0u;
    for (;;) {
        sum = 0u; cnt = 0u; mine = 0u;
#pragma unroll
        for (unsigned j = 0; j < 16; ++j) { const unsigned c = xb_ld(&bar[XB_XCNT(j)]); sum += c; cnt += (c > 0u) ? 1u : 0u; mine = (j == x) ? c : mine; }
        if (sum == G) break;
        __builtin_amdgcn_s_sleep(1);
        if ((++sp & 255u) == 0u) { if (xb_ld(&bar[XB_TMO])) break; if (sp > XB_SPIN_CAP) { atomicAdd(&bar[XB_TMO], 1u); break; } }
    }
    nloc = mine > 0u ? mine : 1u; nx = cnt > 0u ? cnt : 1u;
}

__device__ __forceinline__ void xcd_barrier(const XcdBarrier& b) {
    asm volatile("s_waitcnt vmcnt(0)" ::: "memory");
    __syncthreads();
    if (threadIdx.x == 0) {
        unsigned* bar = b.bar;
        __builtin_amdgcn_s_waitcnt(0);
        unsigned nloc = b.st[0], nx = b.st[1];
        if (nloc == 0u) { xcd_barrier_complete(bar, b.x, nloc, nx); b.st[0] = nloc; b.st[1] = nx; }
        const unsigned old = xb_add(&bar[XB_XSUB(b.x)], 1u);
        const unsigned gen = old / nloc;
        if (old + 1u == (gen + 1u) * nloc) {
            __builtin_amdgcn_fence(__ATOMIC_RELEASE, "agent");
            asm volatile("s_waitcnt vmcnt(0)" ::: "memory");
            const unsigned og = xb_add(&bar[XB_TOP], 1u);
            const unsigned tg = og / nx;
            if (og + 1u == (tg + 1u) * nx) xb_add(&bar[XB_TOPGEN], 1u);
            else XB_SPIN(xb_ld(&bar[XB_TOPGEN]) == tg, bar);
            __builtin_amdgcn_fence(__ATOMIC_ACQUIRE, "agent");
            xb_add(&bar[XB_XGEN(b.x)], 1u);
            asm volatile("s_waitcnt vmcnt(0)" ::: "memory");
        } else {
            XB_SPIN(xb_ld(&bar[XB_XGEN(b.x)]) == gen, bar);
            __builtin_amdgcn_fence(__ATOMIC_ACQUIRE, "agent");
            asm volatile("s_waitcnt vmcnt(0)" ::: "memory");
        }
    }
    __syncthreads();
}

constexpr int NWAVES = 8;
constexpr int BATCH = 32, SEQ = 2048, DM = 1024, T = BATCH * SEQ;
constexpr int PLE = 256, NIN = 4608, NSHIFT = 1792, CW = 512;
constexpr int NEXP = 32, DEXP = 512;
constexpr int PMAX = 2 * T + NEXP * 256;
constexpr int NRT_MAX = PMAX / 256;
constexpr float NORM_EPS = 1e-6f, GN_EPS = 64e-5f;
constexpr float LOG2E = 1.4426950408889634f;
constexpr float QSCALE = 0.125f * LOG2E;

constexpr size_t MiB = 1u << 20;
constexpr size_t WS_CTL = 0, CTL_ZERO_BYTES = 65536;
constexpr size_t WS_RSTD1 = 1 * MiB, WS_RSTD2 = 1 * MiB + 256 * 1024, WS_RSTD3 = 1 * MiB + 512 * 1024;
constexpr size_t WS_WIN = 2 * MiB, WS_WBA = 11 * MiB, WS_WBB = 12 * MiB, WS_WOUT = 13 * MiB, WS_WR = 15 * MiB, WS_WL = 15 * MiB + 512 * 1024;
constexpr size_t WS_WPP = 16 * MiB + 512 * 1024, WS_WPG = 17 * MiB, WS_WGU = 19 * MiB, WS_WD = 83 * MiB;
constexpr size_t WS_SSQ2 = 115 * MiB, WS_SSQ4 = 119 * MiB;
constexpr size_t WS_ROWTOK = 119 * MiB;
constexpr size_t WS_RT_E = 123 * MiB, WS_RT_W = 123 * MiB + 512 * 1024, WS_RT_RANK = 124 * MiB, WS_RT_POS = 124 * MiB + 512 * 1024;
constexpr size_t WS_ROWSCALE = 125 * MiB;
constexpr size_t WS_TABLE = 126 * MiB;
constexpr size_t WS_META = 126 * MiB + 256 * 1024;
constexpr size_t WS_PB = 128 * MiB, WS_XB = 160 * MiB;
constexpr size_t WS_QB = 288 * MiB, WS_KB = 352 * MiB, WS_VB = 368 * MiB, WS_ZS = 384 * MiB;
constexpr size_t WS_R = 608 * MiB, WS_KR = 672 * MiB, WS_VR = 736 * MiB, WS_KK = 800 * MiB, WS_LIN = 864 * MiB;
constexpr size_t WS_ROPE = 608 * MiB;
constexpr size_t WS_DEC = 608 * MiB, WS_BB = 672 * MiB, WS_GG = 896 * MiB;
constexpr size_t WS_Y2 = 736 * MiB, WS_MRG = 384 * MiB;
constexpr size_t WS_X1 = 608 * MiB;
constexpr size_t WS_LOG = 560 * MiB;
constexpr size_t WS_XS = 288 * MiB, WS_HID = 864 * MiB, WS_Y = 288 * MiB, WS_PP = 864 * MiB;
constexpr size_t WS_X3B = 608 * MiB;
constexpr size_t WS_END = 1024 * MiB;
static_assert(WS_XS + (size_t)PMAX * DM * 2 <= WS_LOG && WS_HID + (size_t)PMAX * DEXP * 2 <= WS_END, "ws map");
constexpr int CW_BAR = 4096;

constexpr int RING_OFF = 0, RING_BYTES = 131072;
constexpr int LDSCTL_OFF = RING_BYTES, MISC_OFF = LDSCTL_OFF + 320;
constexpr int INTAB_OFF = RING_BYTES + 512;
constexpr int TILEE_OFF = RING_BYTES + 1024;
constexpr int LDS_BYTES = 147456;

typedef float f32x2 __attribute__((ext_vector_type(2)));
typedef float f32x16 __attribute__((ext_vector_type(16)));
typedef unsigned u32x2 __attribute__((ext_vector_type(2)));
typedef short s16x4 __attribute__((ext_vector_type(4)));

struct Frame {
    LAS unsigned char* lds;
    volatile LAS unsigned* MISC;
    gu32* ctl;
    int wave;
    int vcu, G;
    unsigned char* ws;
    float* out;
};
__device__ __forceinline__ const void* in_ptr(LAS unsigned char* lds, int i) {
    const LAS unsigned* p = (const LAS unsigned*)(lds + INTAB_OFF) + 2 * i; const unsigned lo = __builtin_amdgcn_readfirstlane(p[0]), hi = __builtin_amdgcn_readfirstlane(p[1]);
    return (const void*)(((unsigned long long)hi << 32) | lo); }
#define INF(i) ((const float*)in_ptr(F.lds, (i)))
#define WSP(type, off) ((type*)(F.ws + (off)))

#define fresh_tid() fresh_tid_(F.wave)
__device__ __forceinline__ int fresh_tid_(int wave) { int l; asm volatile("v_mbcnt_lo_u32_b32 %0, -1, 0\n\tv_mbcnt_hi_u32_b32 %0, -1, %0" : "=v"(l)); return wave * 64 + l; }
__device__ __forceinline__ float wave_sum(float v) {
#pragma unroll
    for (int o = 1; o < 64; o <<= 1) v += __shfl_xor(v, o);
    return v;
}
typedef float f32x2c_t __attribute__((ext_vector_type(2))); typedef __bf16 bf16x2c_t __attribute__((ext_vector_type(2)));
__device__ __forceinline__ unsigned cvt_pk(float lo, float hi) { const f32x2c_t v = {lo, hi}; const bf16x2c_t b = __builtin_convertvector(v, bf16x2c_t); return __builtin_bit_cast(unsigned, b); }
__device__ __forceinline__ float bflo(unsigned w) { return __uint_as_float(w << 16); }
__device__ __forceinline__ float bfhi(unsigned w) { return __uint_as_float(w & 0xffff0000u); }
__device__ __forceinline__ float bf1(unsigned short h) { return __uint_as_float((unsigned)h << 16); }
__device__ __forceinline__ float sigmoidf_(float x) { return __builtin_amdgcn_rcpf(1.0f + __expf(-x)); }
__device__ __forceinline__ u32x2 pack4(f32x4 v) { u32x2 w; w.x = cvt_pk(v[0], v[1]); w.y = cvt_pk(v[2], v[3]); return w; }
__device__ __forceinline__ f32x4 unpack4(u32x2 w) { return (f32x4){bflo(w.x), bfhi(w.x), bflo(w.y), bfhi(w.y)}; }

__device__ __forceinline__ int dest_row(int mode, int rowbase, int n) {
    if (mode == 0) return rowbase + n;
    if (mode == 1) { if (n >= 640) return n; const int d = n & 63, dd = d & 31; return (n & ~63) + 32 * (dd >> 4) + 8 * ((dd >> 2) & 3) + 4 * (d >> 5) + (dd & 3); }
    if (mode == 2) return rowbase + 256 * (n >> 7) + (n & 127);
    return rowbase + 256 * (n >> 7) + 128 + (n & 127);
}
struct TrItem { const float* W; int K, N; bf16* WT; int mode, rowbase; int ks; int item; int ldo, koff; };
__device__ __forceinline__ void tr_load(const TrItem& p, int lane, f32x4 (&v)[8]) {
    const int nkb = p.K / 64, kb = p.item % nkb, nb = p.item / nkb, k0 = 64 * kb, n0 = 32 * nb;
#pragma unroll
    for (int i = 0; i < 8; ++i) { const int kk = 8 * i + (lane >> 3); v[i] = *(const GAS f32x4*)(p.W + (size_t)(k0 + kk) * p.N + n0 + 4 * (lane & 7)); }
}
__device__ __forceinline__ void tr_finish(const TrItem& p, int lane, const f32x4 (&v)[8], LAS float* scr, const LAS float* gl) {
    const int nkb = p.K / 64, kb = p.item % nkb, nb = p.item / nkb, k0 = 64 * kb, n0 = 32 * nb;
#pragma unroll
    for (int i = 0; i < 8; ++i) { const int kk = 8 * i + (lane >> 3); const float g = p.ks ? gl[(p.ks - 1) * 1024 + k0 + kk] : 1.0f; LAS float* w = scr + kk * 33 + 4 * (lane & 7);
        w[0] = v[i][0] * g; w[1] = v[i][1] * g; w[2] = v[i][2] * g; w[3] = v[i][3] * g; }
    LDS_WAIT(); asm volatile("" ::: "memory");
    const int c = lane & 7;
#pragma unroll
    for (int j = 0; j < 4; ++j) { const int n = (lane >> 3) + 8 * j; const LAS float* s = scr + (8 * c) * 33 + n;
        v4u o; o.x = pk2(s[0 * 33], s[1 * 33]); o.y = pk2(s[2 * 33], s[3 * 33]); o.z = pk2(s[4 * 33], s[5 * 33]); o.w = pk2(s[6 * 33], s[7 * 33]);
        *(GAS v4u*)(p.WT + (size_t)dest_row(p.mode, p.rowbase, n0 + n) * p.ldo + p.koff + k0 + 8 * c) = o; }
    LDS_WAIT(); asm volatile("" ::: "memory");
}

__device__ __forceinline__ void p0_prologue(Frame& F) {
    LAS float* scr = (LAS float*)(F.lds + RING_OFF + F.wave * 16384);
    const int tid = fresh_tid(), lane = tid & 63;
    const int gw = F.vcu * NWAVES + F.wave, NGW = F.G * NWAVES;
    constexpr int I_WIN = 16 * 144, I_WB = 8 * 32, I_WO = 16 * 32, I_PP = 4 * 32, I_EG = 16 * 16, I_ED = 8 * 32;
    constexpr int NITEMS = I_WIN + 2 * I_WB + 2 * I_WO + I_PP + NEXP * (2 * I_EG + I_ED);
    const float* w_in = INF(4); const float* lnmix = INF(3); const float* wba = INF(17); const float* wbb = INF(18); const float* wout = INF(19); const float* wpg = INF(29); const float* lnple = INF(28);
    const float* wpp = INF(30); const float* wge = INF(25); const float* wue = INF(26); const float* wde = INF(27); const float* lnmoe = INF(20);
    LAS float* gl = (LAS float*)(F.lds + RING_BYTES + 1024);
    for (int i = tid; i < 1024; i += NWAVES * 64) { gl[i] = lnmix[i]; gl[1024 + i] = lnple[i]; gl[2048 + i] = lnmoe[i]; }
    __syncthreads();
    auto decode = [&](int it) -> TrItem { int r = it;
        if (r < I_WIN) return TrItem{w_in, DM, NIN, WSP(bf16, WS_WIN), 1, 0, 1, r, DM, 0}; r -= I_WIN;
        if (r < I_WB) return TrItem{wba, CW, DM, WSP(bf16, WS_WBA), 0, 0, 0, r, DM, 0}; r -= I_WB;
        if (r < I_WB) return TrItem{wbb, CW, DM, WSP(bf16, WS_WBA), 0, 0, 0, r, DM, CW}; r -= I_WB;
        if (r < I_WO) return TrItem{wout, DM, DM, WSP(bf16, WS_WOUT), 0, 0, 0, r, DM, 0}; r -= I_WO;
        if (r < I_WO) return TrItem{wpg, DM, DM, WSP(bf16, WS_WPG), 0, 0, 2, r, DM, 0}; r -= I_WO;
        if (r < I_PP) return TrItem{wpp, PLE, DM, WSP(bf16, WS_WPP), 0, 0, 0, r, PLE, 0}; r -= I_PP;
        if (r < NEXP * I_EG) { const int e = r / I_EG; return TrItem{wge + (size_t)e * DM * DEXP, DM, DEXP, WSP(bf16, WS_WGU), 2, e * 1024, 3, r % I_EG, DM, 0}; } r -= NEXP * I_EG;
        if (r < NEXP * I_EG) { const int e = r / I_EG; return TrItem{wue + (size_t)e * DM * DEXP, DM, DEXP, WSP(bf16, WS_WGU), 3, e * 1024, 3, r % I_EG, DM, 0}; } r -= NEXP * I_EG;
        const int e = r / I_ED; return TrItem{wde + (size_t)e * DEXP * DM, DEXP, DM, WSP(bf16, WS_WD), 0, e * 1024, 0, r % I_ED, DEXP, 0}; };
#ifndef P0DBL
#define P0DBL 0
#endif
    _Pragma("unroll 1") for (int rp_ = 0; rp_ <= (P0DBL & 1); ++rp_)
    {
        constexpr int IPW = (NITEMS + 2048 - 1) / 2048;
        const int ipw = (NITEMS + NGW - 1) / NGW, i0 = gw * ipw, iend = (i0 + ipw < NITEMS) ? i0 + ipw : NITEMS; (void)IPW;
        if (i0 < iend) {
        TrItem ca = decode(i0), cb = ca, cc = ca; f32x4 a[8], b[8], c[8]; bool va = true, vb, vc = false;
        tr_load(ca, lane, a);
        vb = (i0 + 1) < iend;
        if (vb) { cb = decode(i0 + 1); tr_load(cb, lane, b); }
        int itn = i0 + 2;
#define TR_STEP(X, CX, vY, Z, CZ, vZ) { vZ = itn < iend; if (vZ) { CZ = decode(itn); tr_load(CZ, lane, Z); } itn += 1; tr_finish(CX, lane, X, scr, gl); if (!(vY)) break; }
        for (;;) {
            TR_STEP(a, ca, vb, c, cc, vc)
            TR_STEP(b, cb, vc, a, ca, va)
            TR_STEP(c, cc, va, b, cb, vb)
        }
#undef TR_STEP
        } }
    const int gt = F.vcu * (NWAVES * 64) + tid, NGT = F.G * NWAVES * 64;
    const float* wdu = INF(7); const float* wau = INF(9); const float* wgu = INF(10); const float* wgr = INF(21); const float* wex = INF(23); const float* lnm = INF(20);
    const float* pin = INF(1); const float* xin = INF(0); const int* posin = (const int*)INF(2);
    for (int it = gt; it < 1536 * 32; it += NGT) {
        const int row = it >> 5, k8 = (it & 31) * 8; const int blk = row >> 9, n = row & 511;
        float v[8];
#pragma unroll
        for (int j = 0; j < 8; ++j) { const int k = k8 + j; float x = 0.f;
            if (blk == 0 && k < 64) x = wdu[(size_t)k * CW + n];
            else if (blk == 1 && k >= 64 && k < 128) x = wau[(size_t)(k - 64) * CW + n];
            else if (blk == 2 && k >= 128) x = wgu[(size_t)(k - 128) * CW + n];
            v[j] = x; }
        v4u o; o.x = pk2(v[0], v[1]); o.y = pk2(v[2], v[3]); o.z = pk2(v[4], v[5]); o.w = pk2(v[6], v[7]);
        *(GAS v4u*)(WSP(bf16, WS_WL) + (size_t)row * 256 + k8) = o;
    }
    for (int it = gt; it < 256 * 128; it += NGT) {
        const int row = it >> 7, k8 = (it & 127) * 8; float v[8];
#pragma unroll
        for (int j = 0; j < 8; ++j) { const int k = k8 + j; float x = 0.f;
            if (row < 4) x = wgr[(size_t)k * 4 + row] * lnm[k];
            else if (row < 36) x = wex[(size_t)k * NEXP + (row - 4)] * lnm[k];
            v[j] = x; }
        v4u o; o.x = pk2(v[0], v[1]); o.y = pk2(v[2], v[3]); o.z = pk2(v[4], v[5]); o.w = pk2(v[6], v[7]);
        *(GAS v4u*)(WSP(bf16, WS_WR) + (size_t)row * DM + k8) = o;
    }
    _Pragma("unroll 1") for (int rp_ = 0; rp_ <= ((P0DBL >> 1) & 1); ++rp_)
#pragma unroll 8
    for (int it = gt; it < T * PLE / 8; it += NGT) {
        const GAS f32x4* s = (const GAS f32x4*)pin + (size_t)it * 2; const f32x4 a = s[0], b = s[1];
        v4u o; o.x = pk2(a[0], a[1]); o.y = pk2(a[2], a[3]); o.z = pk2(b[0], b[1]); o.w = pk2(b[2], b[3]);
        *(GAS v4u*)(WSP(bf16, WS_PB) + (size_t)it * 8) = o;
    }
    _Pragma("unroll 1") for (int rp_ = 0; rp_ <= ((P0DBL >> 2) & 1); ++rp_)
#pragma unroll 4
    for (int it = gt; it < T * 32; it += NGT) {
        const int t = it >> 5, i = it & 31; const int pos = posin[t];
        const float inv = exp2f(-(float)i * (13.287712379549449f / 32.0f));
        const float ang = (float)pos * inv;
        const float rev = ang * 0.15915494309189535f; const float fr = rev - floorf(rev);
        const float s = __builtin_amdgcn_sinf(fr), c = __builtin_amdgcn_cosf(fr);
        WSP(float, WS_ROPE)[(size_t)t * 64 + i] = c; WSP(float, WS_ROPE)[(size_t)t * 64 + 32 + i] = s;
    }
    _Pragma("unroll 1") for (int rp_ = 0; rp_ <= ((P0DBL >> 3) & 1); ++rp_)
    for (int m = 4 * gw; m < T; m += 4 * NGW) {
        f32x4 v[4][4]; float s[4];
#pragma unroll
        for (int q = 0; q < 4; ++q) { const GAS f32x4* xr = (const GAS f32x4*)(xin + (size_t)(m + q) * DM) + lane;
#pragma unroll
            for (int j = 0; j < 4; ++j) v[q][j] = xr[64 * j]; }
#pragma unroll
        for (int q = 0; q < 4; ++q) { s[q] = 0.f;
#pragma unroll
            for (int j = 0; j < 4; ++j) s[q] += (v[q][j].x * v[q][j].x + v[q][j].y * v[q][j].y) + (v[q][j].z * v[q][j].z + v[q][j].w * v[q][j].w); }
#pragma unroll
        for (int o = 1; o < 64; o <<= 1) {
#pragma unroll
            for (int q = 0; q < 4; ++q) s[q] += __shfl_xor(s[q], o); }
        { float sv = s[0]; if (lane == 1) sv = s[1]; asm volatile("" : "+v"(sv)); if (lane == 2) sv = s[2]; asm volatile("" : "+v"(sv)); if (lane == 3) sv = s[3];
          if (lane < 4) WSP(float, WS_RSTD1)[m + lane] = 1.0f / sqrtf(sv * (1.0f / DM) + NORM_EPS); }
#pragma unroll
        for (int q = 0; q < 4; ++q) {
            GAS unsigned long long* o8 = (GAS unsigned long long*)(WSP(bf16, WS_XB) + (size_t)(m + q) * DM) + lane;
#pragma unroll
            for (int j = 0; j < 4; ++j) o8[64 * j] = (unsigned long long)pk2(v[q][j].x, v[q][j].y) | ((unsigned long long)pk2(v[q][j].z, v[q][j].w) << 32); }
    }
}

#define EPI_LOOP_ROWS for (int ai = 0; ai < 2; ++ai) _Pragma("unroll") for (int m = 0; m < 4; ++m)
__device__ __forceinline__ v4u pack8(f32x4 a, f32x4 b) { v4u w; w.x = cvt_pk(a[0], a[1]); w.y = cvt_pk(a[2], a[3]); w.z = cvt_pk(b[0], b[1]); w.w = cvt_pk(b[2], b[3]); return w; }
__device__ __forceinline__ f32x4 unlo(v4u w) { return (f32x4){bflo(w.x), bfhi(w.x), bflo(w.y), bfhi(w.y)}; }
__device__ __forceinline__ f32x4 unhi(v4u w) { return (f32x4){bflo(w.z), bfhi(w.z), bflo(w.w), bfhi(w.w)}; }
__device__ __forceinline__ f32x4 sig4(f32x4 v) { f32x4 g; g[0] = sigmoidf_(v[0]); g[1] = sigmoidf_(v[1]); g[2] = sigmoidf_(v[2]); g[3] = sigmoidf_(v[3]); return g; }

__device__ __forceinline__ size_t gate_blk(int pm, int g, int ai, int bj, int m, int wr, int wc) { return ((size_t)((((((pm * 8 + g) * 2 + ai) * 2 + bj) * 4 + m) * 2 + wr) * 4 + wc)) * 512; }
struct EpiZ {
    static constexpr bool PERM = true, AFTER_DRAIN = false; static constexpr int MIDK_T = 0;
    const float* rstd; const float* rope; bf16 *Qb, *Kb, *Vb, *Zs, *Gt;
    __device__ __forceinline__ void operator()(const f32x4 (&acc)[2][2][4][2], const pg8::Unit& u, int wr, int wc, int fr, int fq) const {
        const int pn = u.pn; const int row0 = u.pm * 256 + wr * 64 + fr;
        float rsv[2][4];
#pragma unroll
        EPI_LOOP_ROWS rsv[ai][m] = rstd[row0 + ai * 128 + m * 16];
        if (pn < 3) {
            const int d0 = 16 * (wc & 1) + 4 * fq;
#pragma unroll
            for (int ai = 0; ai < 2; ++ai) { f32x4 csv[4], snv[4];
#pragma unroll
              for (int m = 0; m < 4; ++m) { const float* rp = rope + (size_t)(row0 + ai * 128 + m * 16) * 64 + d0; csv[m] = *(const f32x4*)rp; snv[m] = *(const f32x4*)(rp + 32); }
#pragma unroll
              for (int m = 0; m < 4; ++m) { const int row = row0 + ai * 128 + m * 16; const float rs = rsv[ai][m];
                const f32x4 cs = csv[m], sn = snv[m];
#pragma unroll
                for (int bj = 0; bj < 2; ++bj) { const f32x4 v0 = acc[ai][bj][m][0] * rs, v1 = acc[ai][bj][m][1] * rs;
                    if (pn < 2) { const int head = pn * 4 + bj * 2 + (wc >> 1); const f32x4 o0 = (v0 * cs - v1 * sn) * QSCALE, o1 = (v1 * cs + v0 * sn) * QSCALE;
                        bf16* p = Qb + (size_t)row * CW + head * 64 + d0; *(u32x2*)p = pack4(o0); *(u32x2*)(p + 32) = pack4(o1); }
                    else if (bj == 0) { const int kvh = wc >> 1; const f32x4 o0 = v0 * cs - v1 * sn, o1 = v1 * cs + v0 * sn;
                        bf16* p = Kb + (size_t)row * 128 + kvh * 64 + d0; *(u32x2*)p = pack4(o0); *(u32x2*)(p + 32) = pack4(o1); }
                    else { *(v4u*)(Vb + (size_t)row * 128 + wc * 32 + 8 * fq) = pack8(v0, v1); } } } }
        } else if (pn < 10) {
#pragma unroll
            EPI_LOOP_ROWS { const int row = row0 + ai * 128 + m * 16; const float rs = rsv[ai][m];
#pragma unroll
                for (int bj = 0; bj < 2; ++bj) *(v4u*)(Zs + (size_t)row * NSHIFT + (pn - 3) * 256 + bj * 128 + wc * 32 + 8 * fq) = pack8(acc[ai][bj][m][0] * rs, acc[ai][bj][m][1] * rs); }
        } else {
#pragma unroll
            EPI_LOOP_ROWS { const int row = row0 + ai * 128 + m * 16; const float rs = rsv[ai][m];
#pragma unroll
                for (int bj = 0; bj < 2; ++bj) { const float nk = rs * -LOG2E; f32x4 g0, g1; u32x2 w;
#pragma unroll
                    for (int j = 0; j < 4; ++j) { g0[j] = __builtin_amdgcn_rcpf(__builtin_fmaf(__builtin_amdgcn_exp2f(acc[ai][bj][m][0][j] * nk), 1.0f / 255.0f, 1.0f / 255.0f));
                        g1[j] = __builtin_amdgcn_rcpf(__builtin_fmaf(__builtin_amdgcn_exp2f(acc[ai][bj][m][1][j] * nk), 1.0f / 255.0f, 1.0f / 255.0f)); }
                    w.x = __builtin_amdgcn_cvt_pk_u8_f32(g0[3], 3, __builtin_amdgcn_cvt_pk_u8_f32(g0[2], 2, __builtin_amdgcn_cvt_pk_u8_f32(g0[1], 1, __builtin_amdgcn_cvt_pk_u8_f32(g0[0], 0, 0u))));
                    w.y = __builtin_amdgcn_cvt_pk_u8_f32(g1[3], 3, __builtin_amdgcn_cvt_pk_u8_f32(g1[2], 2, __builtin_amdgcn_cvt_pk_u8_f32(g1[1], 1, __builtin_amdgcn_cvt_pk_u8_f32(g1[0], 0, 0u))));
                    *(u32x2*)((unsigned char*)Gt + gate_blk(u.pm, pn - 10, ai, bj, m, wr, wc) + (fr * 32 + fq * 8)) = w; } }
        }
    }
};

struct EpiLora {
    static constexpr bool PERM = true, AFTER_DRAIN = false; static constexpr int MIDK_T = 0;
    const float *w0, *a0, *k_a; bf16* DEC; bf16 *Kr, *KKb, *Bb, *Gg;
    __device__ __forceinline__ void operator()(const f32x4 (&acc)[2][2][4][2], const pg8::Unit& u, int wr, int wc, int fr, int fq) const {
        const int pn = u.pn; const int row0 = u.pm * 256 + wr * 64 + fr;
#pragma unroll
        for (int bj = 0; bj < 2; ++bj) { int c = (pn & 1) * 256 + bj * 128 + wc * 32 + 8 * fq; asm volatile("" : "+v"(c));
            f32x4 bias[2];
#pragma unroll
            for (int n = 0; n < 2; ++n) bias[n] = (pn < 2) ? *(const f32x4*)(w0 + c + 4 * n) : (pn < 4) ? *(const f32x4*)(a0 + c + 4 * n) : (f32x4){0.f, 0.f, 0.f, 0.f};
#pragma unroll
            EPI_LOOP_ROWS { const int row = row0 + ai * 128 + m * 16;
                if (pn < 2) { f32x4 o[2];
#pragma unroll
                    for (int n = 0; n < 2; ++n) { const f32x4 v = acc[ai][bj][m][n] + bias[n];
#pragma unroll
                        for (int j = 0; j < 4; ++j) o[n][j] = -0.6065306597126334f * sigmoidf_(v[j]); }
                    *(v4u*)(DEC + (size_t)row * CW + c) = pack8(o[0], o[1]); }
                else if (pn < 4) { f32x4 av[2];
#pragma unroll
                    for (int n = 0; n < 2; ++n) av[n] = sig4(bias[n] + acc[ai][bj][m][n]);
                    *(v4u*)(Bb + (size_t)row * CW + c) = pack8(av[0], av[1]); }
                else { *(v4u*)(Gg + (size_t)row * CW + c) = pack8(acc[ai][bj][m][0], acc[ai][bj][m][1]); }
                asm volatile("" ::: "memory"); } }
    }
};
__device__ __forceinline__ f32x4 u8x4f(unsigned w) { return (f32x4){(float)(w & 0xffu), (float)((w >> 8) & 0xffu), (float)((w >> 16) & 0xffu), (float)(w >> 24)}; }
struct EpiMerge2 {
    static constexpr bool PERM = true, AFTER_DRAIN = false; static constexpr int MIDK_T = 8;
    const unsigned char* Gt; bf16* M;
    __device__ __forceinline__ void mid(f32x4 (&acc)[2][2][4][2], const pg8::Unit& u, int wr, int wc, int fr, int fq) const {
        int lo = fr * 32 + fq * 8; asm volatile("" : "+v"(lo));
        u32x2 ga[2][4][2], gb[2][4][2];
#pragma unroll
        EPI_LOOP_ROWS {
#pragma unroll
            for (int bj = 0; bj < 2; ++bj) { ga[ai][m][bj] = *(const u32x2*)(Gt + gate_blk(u.pm, u.pn, ai, bj, m, wr, wc) + lo); gb[ai][m][bj] = *(const u32x2*)(Gt + gate_blk(u.pm, 4 + u.pn, ai, bj, m, wr, wc) + lo); } }
#pragma unroll
        EPI_LOOP_ROWS {
#pragma unroll
            for (int bj = 0; bj < 2; ++bj) {
#pragma unroll
                for (int n = 0; n < 2; ++n) { const f32x4 a = u8x4f(n ? ga[ai][m][bj].y : ga[ai][m][bj].x), b = u8x4f(n ? gb[ai][m][bj].y : gb[ai][m][bj].x); f32x4 r;
#pragma unroll
                    for (int j = 0; j < 4; ++j) r[j] = a[j] * __builtin_amdgcn_rcpf(fmaxf(b[j], 1.0f));
                    acc[ai][bj][m][n] *= r; } } }
    }
    __device__ __forceinline__ void operator()(const f32x4 (&acc)[2][2][4][2], const pg8::Unit& u, int wr, int wc, int fr, int fq) const {
        const int row0 = u.pm * 256 + wr * 64 + fr;
        u32x2 gb[2][4][2];
#pragma unroll
        EPI_LOOP_ROWS {
#pragma unroll
            for (int bj = 0; bj < 2; ++bj) gb[ai][m][bj] = *(const u32x2*)(Gt + gate_blk(u.pm, 4 + u.pn, ai, bj, m, wr, wc) + (fr * 32 + fq * 8)); }
#pragma unroll
        EPI_LOOP_ROWS { const int row = row0 + ai * 128 + m * 16;
#pragma unroll
            for (int bj = 0; bj < 2; ++bj) { const int c = u.pn * 256 + bj * 128 + wc * 32 + 8 * fq;
                const f32x4 b0 = u8x4f(gb[ai][m][bj].x), b1 = u8x4f(gb[ai][m][bj].y); f32x4 s0, s1;
#pragma unroll
                for (int j = 0; j < 4; ++j) { s0[j] = fmaxf(b0[j], 1.0f) * (1.0f / 255.0f); s1[j] = fmaxf(b1[j], 1.0f) * (1.0f / 255.0f); }
                *(v4u*)(M + (size_t)row * DM + c) = pack8(acc[ai][bj][m][0] * s0, acc[ai][bj][m][1] * s1); }
            asm volatile("" ::: "memory"); }
    }
};

struct EpiOut {
    static constexpr bool PERM = true, AFTER_DRAIN = false; static constexpr int MIDK_T = 0;
    bf16* X1b; float* ssq;
    __device__ __forceinline__ void operator()(const f32x4 (&acc)[2][2][4][2], const pg8::Unit& u, int wr, int wc, int fr, int fq) const {
        const int row0 = u.pm * 256 + wr * 64 + fr;
        bf16* xp = X1b + (size_t)row0 * DM + u.pn * 256 + wc * 32 + 8 * fq;
        v4u xw[2][4][2];
#pragma unroll
        EPI_LOOP_ROWS {
#pragma unroll
            for (int bj = 0; bj < 2; ++bj) xw[ai][m][bj] = *(const v4u*)(xp + (size_t)(ai * 128 + m * 16) * DM + bj * 128); }
#pragma unroll
        EPI_LOOP_ROWS { const int row = row0 + ai * 128 + m * 16; float s = 0.f;
#pragma unroll
            for (int bj = 0; bj < 2; ++bj) {
                const f32x4 o0 = unlo(xw[ai][m][bj]) + acc[ai][bj][m][0], o1 = unhi(xw[ai][m][bj]) + acc[ai][bj][m][1];
                *(v4u*)(xp + (size_t)(ai * 128 + m * 16) * DM + bj * 128) = pack8(o0, o1);
                s += ((o0[0] * o0[0] + o0[1] * o0[1]) + (o0[2] * o0[2] + o0[3] * o0[3])) + ((o1[0] * o1[0] + o1[1] * o1[1]) + (o1[2] * o1[2] + o1[3] * o1[3])); }
            s += __shfl_xor(s, 16); s += __shfl_xor(s, 32);
            if (fq == 0) ssq[(size_t)(u.pn * 4 + wc) * T + row] = s;        }
    }
};

struct EpiRouter {
    static constexpr bool PERM = true, AFTER_DRAIN = false; static constexpr int MIDK_T = 0;
    const float* ssq; const float *bg, *be; float* rstd2; float* LOG;
    __device__ __forceinline__ void operator()(const f32x4 (&acc)[2][2][4][2], const pg8::Unit& u, int wr, int wc, int fr, int fq) const {
        if (wc >= 2) return;
        const int row0 = u.pm * 256 + wr * 64 + fr;
        float sv[2][4];
#pragma unroll
        EPI_LOOP_ROWS { const int row = row0 + ai * 128 + m * 16; sv[ai][m] = (ssq[(size_t)(4 * fq) * T + row] + ssq[(size_t)(4 * fq + 1) * T + row]) + (ssq[(size_t)(4 * fq + 2) * T + row] + ssq[(size_t)(4 * fq + 3) * T + row]); }
#pragma unroll
        EPI_LOOP_ROWS { const int row = row0 + ai * 128 + m * 16;
            float s = sv[ai][m];
            s += __shfl_xor(s, 16); s += __shfl_xor(s, 32);
            const float rs = 1.0f / sqrtf(s * (1.0f / DM) + NORM_EPS);
            if (wc == 0 && fq == 0) rstd2[row] = rs;
#pragma unroll
            for (int n = 0; n < 2; ++n) { const int c0 = wc * 32 + 8 * fq + 4 * n; if (c0 >= 36) continue; f32x4 o;
#pragma unroll
                for (int j = 0; j < 4; ++j) { const int cc = c0 + j; o[j] = acc[ai][0][m][n][j] * rs + (cc < 4 ? bg[cc] : be[cc - 4]); }
                *(f32x4*)(LOG + (size_t)row * 64 + c0) = o; } }
    }
};

struct EpiGU {
    static constexpr bool PERM = true, AFTER_DRAIN = false; static constexpr int MIDK_T = 0;
    const float* rowscale; bf16* HID;
    __device__ __forceinline__ void operator()(const f32x4 (&acc)[2][2][4][2], const pg8::Unit& u, int wr, int wc, int fr, int fq) const {
        const int row0 = u.pm * 256 + wr * 64 + fr;
        float rsv[2][4];
#pragma unroll
        EPI_LOOP_ROWS rsv[ai][m] = rowscale[row0 + ai * 128 + m * 16];
#pragma unroll
        EPI_LOOP_ROWS { const int row = row0 + ai * 128 + m * 16; const float rs = rsv[ai][m]; f32x4 h[2];
#pragma unroll
            for (int n = 0; n < 2; ++n) { const f32x4 g = acc[ai][0][m][n] * rs, up = acc[ai][1][m][n] * rs;
#pragma unroll
                for (int j = 0; j < 4; ++j) h[n][j] = g[j] * sigmoidf_(g[j]) * up[j]; }
            *(v4u*)(HID + (size_t)row * DEXP + u.pn * 128 + wc * 32 + 8 * fq) = pack8(h[0], h[1]); }
    }
};

struct EpiProbe {
    static constexpr bool PERM = true, AFTER_DRAIN = false; static constexpr int MIDK_T = 0;
    float* O;
    __device__ __forceinline__ void operator()(const f32x4 (&acc)[2][2][4][2], const pg8::Unit& u, int wr, int wc, int fr, int fq) const {
        f32x4 s = (f32x4){0.f, 0.f, 0.f, 0.f};
#pragma unroll
        for (int ai = 0; ai < 2; ++ai)
#pragma unroll
            for (int bj = 0; bj < 2; ++bj)
#pragma unroll
                for (int m = 0; m < 4; ++m) s += acc[ai][bj][m][0] + acc[ai][bj][m][1];
        if (s[0] + s[1] + s[2] + s[3] == 12345.678f) O[u.pm + wr + wc + fr + fq] = s[0];
    }
};
struct EpiStore {
    static constexpr bool PERM = true, AFTER_DRAIN = false; static constexpr int MIDK_T = 0;
    bf16* O; int ldc;
    __device__ __forceinline__ void operator()(const f32x4 (&acc)[2][2][4][2], const pg8::Unit& u, int wr, int wc, int fr, int fq) const {
        const int row0 = u.pm * 256 + wr * 64 + fr;
#pragma unroll
        EPI_LOOP_ROWS { const int row = row0 + ai * 128 + m * 16;
#pragma unroll
            for (int bj = 0; bj < 2; ++bj) *(v4u*)(O + (size_t)row * ldc + u.pn * 256 + bj * 128 + wc * 32 + 8 * fq) = pack8(acc[ai][bj][m][0], acc[ai][bj][m][1]); }
    }
};

__device__ __forceinline__ size_t pp_blk(int pm, int pn, int ai, int bj, int m, int wr, int wc) { return ((size_t)((((((pm * 4 + pn) * 2 + ai) * 2 + bj) * 4 + m) * 2 + wr) * 4 + wc)) * 512; }
struct EpiStoreBlk {
    static constexpr bool PERM = true, AFTER_DRAIN = false; static constexpr int MIDK_T = 0;
    bf16* O;
    __device__ __forceinline__ void operator()(const f32x4 (&acc)[2][2][4][2], const pg8::Unit& u, int wr, int wc, int fr, int fq) const {
#pragma unroll
        EPI_LOOP_ROWS {
#pragma unroll
            for (int bj = 0; bj < 2; ++bj) *(v4u*)(O + pp_blk(u.pm, u.pn, ai, bj, m, wr, wc) + (fr * 32 + fq * 8)) = pack8(acc[ai][bj][m][0], acc[ai][bj][m][1]); }
    }
};
struct EpiPle {
    static constexpr bool PERM = true, AFTER_DRAIN = false; static constexpr int MIDK_T = 0;
    const float* rstd3; const bf16* X2b; const bf16* PP; bf16* X3b; float* ssq;
    __device__ __forceinline__ void operator()(const f32x4 (&acc)[2][2][4][2], const pg8::Unit& u, int wr, int wc, int fr, int fq) const {
        const int row0 = u.pm * 256 + wr * 64 + fr;
        const size_t off0 = (size_t)row0 * DM + u.pn * 256 + wc * 32 + 8 * fq;
#pragma unroll
        for (int ai = 0; ai < 2; ++ai) {
            v4u pw[4][2], xw[4][2]; float rsv[4];
#pragma unroll
            for (int m = 0; m < 4; ++m) { rsv[m] = rstd3[row0 + ai * 128 + m * 16];
#pragma unroll
                for (int bj = 0; bj < 2; ++bj) { const size_t o_ = off0 + (size_t)(ai * 128 + m * 16) * DM + bj * 128; pw[m][bj] = *(const v4u*)(PP + pp_blk(u.pm, u.pn, ai, bj, m, wr, wc) + (fr * 32 + fq * 8)); xw[m][bj] = *(const v4u*)(X2b + o_); } }
#pragma unroll
            for (int m = 0; m < 4; ++m) { const int row = row0 + ai * 128 + m * 16; const float rs = rsv[m]; float s = 0.f;
#pragma unroll
                for (int bj = 0; bj < 2; ++bj) { f32x4 o[2];
#pragma unroll
                    for (int n = 0; n < 2; ++n) { const f32x4 pp = n ? unhi(pw[m][bj]) : unlo(pw[m][bj]), x2 = n ? unhi(xw[m][bj]) : unlo(xw[m][bj]), v = acc[ai][bj][m][n] * rs;
#pragma unroll
                        for (int j = 0; j < 4; ++j) o[n][j] = x2[j] + sigmoidf_(v[j]) * pp[j];
                        s += (o[n][0] * o[n][0] + o[n][1] * o[n][1]) + (o[n][2] * o[n][2] + o[n][3] * o[n][3]); }
                    *(v4u*)(X3b + off0 + (size_t)(ai * 128 + m * 16) * DM + bj * 128) = pack8(o[0], o[1]); }
                s += __shfl_xor(s, 16); s += __shfl_xor(s, 32);
                if (fq == 0) ssq[(size_t)(u.pn * 4 + wc) * T + row] = s;        }
            asm volatile("" ::: "memory"); }
    }
};

__device__ __forceinline__ int opaque_s(int v) { asm volatile("" : "+s"(v)); return v; }
struct PanelOrder {
    static constexpr bool GATHER = false; __device__ __forceinline__ const int* rowtok() const { return nullptr; }
    int pm, nN;
    __device__ __forceinline__ bool next(int i, pg8::Unit& u) const { if (i >= nN) return false; u.pm = opaque_s(pm); u.pn = i; u.pb = i; return true; }
    __device__ __forceinline__ void a_ready(const pg8::Unit&) const {}
    __device__ __forceinline__ void done(const pg8::Unit&) const {}
};
__device__ __forceinline__ void wg_handover() { asm volatile("s_waitcnt vmcnt(0)" ::: "memory"); __syncthreads(); __builtin_amdgcn_fence(__ATOMIC_ACQUIRE, "agent"); asm volatile("s_waitcnt vmcnt(0)" ::: "memory"); __syncthreads(); }

template <bool GTH> struct MoeOrderT {
    static constexpr bool GATHER = GTH; const int* rtok; __device__ __forceinline__ const int* rowtok() const { return rtok; }
    int nunits, G, c; const LAS int* tile_e;
    __device__ __forceinline__ bool next(int i, pg8::Unit& u) const {
        const long L = (long)i * G + c; if (L >= nunits) return false;
        const int rt = (int)(L >> 2), pn = (int)(L & 3); u.pm = rt; u.pn = pn; u.pb = tile_e[rt] * 4 + pn; return true; }
    __device__ __forceinline__ void a_ready(const pg8::Unit&) const {}
    __device__ __forceinline__ void done(const pg8::Unit&) const {}
};

__device__ __forceinline__ void unpack8(const v4u w, float (&v)[8]) { v[0] = bflo(w.x); v[1] = bfhi(w.x); v[2] = bflo(w.y); v[3] = bfhi(w.y); v[4] = bflo(w.z); v[5] = bfhi(w.z); v[6] = bflo(w.w); v[7] = bfhi(w.w); }
__device__ __forceinline__ void store8(bf16* p, const float (&v)[8]) { v4u o; o.x = cvt_pk(v[0], v[1]); o.y = cvt_pk(v[2], v[3]); o.z = cvt_pk(v[4], v[5]); o.w = cvt_pk(v[6], v[7]); *(GAS v4u*)p = o; }
__device__ __forceinline__ void shift8v(const v4u cw, const v4u pw, const f32x4 m0, const f32x4 m1, float (&o)[8]) {
    float c[8], p[8]; unpack8(cw, c); unpack8(pw, p);
#pragma unroll
    for (int j = 0; j < 8; ++j) o[j] = c[j] + (p[j] - c[j]) * (j < 4 ? m0[j] : m1[j - 4]);
}
__device__ __forceinline__ void rp1_phase(Frame& F, int pm) {
    const int lane = fresh_tid() & 63, l3 = lane & 31, sub = lane >> 5;
    const bf16* Zs = WSP(bf16, WS_ZS); const float* mup = INF(5);
    const int col = 1536 + 8 * l3;
    const f32x4 m0 = *(const f32x4*)(mup + col), m1 = *(const f32x4*)(mup + col + 4);
    for (int t0 = 256 * pm + 8 * F.wave; t0 < 256 * pm + 256; t0 += 8 * NWAVES) {
        v4u cw[4], pw[4];
#pragma unroll
        for (int q = 0; q < 4; ++q) { const int t = t0 + 2 * q + sub; cw[q] = *(const GAS v4u*)(Zs + (size_t)t * NSHIFT + col);
            pw[q] = (v4u){0u, 0u, 0u, 0u}; if ((t & (SEQ - 1)) != 0) pw[q] = *(const GAS v4u*)(Zs + (size_t)(t - 1) * NSHIFT + col); }
#pragma unroll
        for (int q = 0; q < 4; ++q) { const int t = t0 + 2 * q + sub; float v[8];
            shift8v(cw[q], pw[q], m0, m1, v);
#pragma unroll
            for (int j = 0; j < 8; ++j) { if (l3 < 8) v[j] = tanhf(v[j]); else if (l3 >= 16) v[j] = sigmoidf_(v[j]); }
            store8(WSP(bf16, WS_LIN) + (size_t)t * 256 + 8 * l3, v); }
    }
}

__device__ __forceinline__ void attn_phase(Frame& F) {
    LAS unsigned char* L = F.lds + RING_OFF;
    const int tid = fresh_tid(), lane = tid & 63, wave = F.wave, r = lane & 31, h = lane >> 5;
    const float* sinks = INF(16);
    const bf16* Qb = WSP(bf16, WS_QB); const bf16* Kb = WSP(bf16, WS_KB); const bf16* Vb = WSP(bf16, WS_VB); bf16* Yatt = WSP(bf16, WS_Y2);
    constexpr int NUN = BATCH * 2 * 16;
#define ATT_KVLOAD(Uu) do { const int n_ = (Uu) & 15, kvh_ = ((Uu) >> 4) & 1, b_ = (Uu) >> 5; const int tb_ = b_ * SEQ + n_ * 128; \
        _Pragma("unroll") for (int i = 0; i < 4; ++i) { const int q = tid + 512 * i, row = q >> 3, c16 = q & 7; const int tok = tb_ - 128 + row; \
            kp[i] = (v4u){0u, 0u, 0u, 0u}; vp[i] = (v4u){0u, 0u, 0u, 0u}; \
            if (n_ > 0 || i >= 2) { kp[i] = *(const GAS v4u*)(Kb + (size_t)tok * 128 + kvh_ * 64 + c16 * 8); vp[i] = *(const GAS v4u*)(Vb + (size_t)tok * 128 + kvh_ * 64 + c16 * 8); } } } while (0)
#define ATT_KVWRITE do { _Pragma("unroll") for (int i = 0; i < 4; ++i) { const int q = tid + 512 * i, row = q >> 3, c16 = q & 7; \
            *(LAS v4u*)(Ksm + row * 128 + ((c16 ^ ((row >> 1) & 7)) << 4)) = kp[i]; \
            *(LAS v4u*)(Vsm + row * 128 + ((c16 ^ (((row >> 1) & 1) << 2)) << 4)) = vp[i]; } } while (0)
#define ATT_QLOAD(dst, Uu, qsv) do { const int n_ = (Uu) & 15, kvh_ = ((Uu) >> 4) & 1, b_ = (Uu) >> 5; const int q0_ = b_ * SEQ + n_ * 128 + (wave & 1) * 64 + 32 * (qsv), hq_ = kvh_ * 4 + (wave >> 1); \
        _Pragma("unroll") for (int j = 0; j < 4; ++j) dst[j] = *(const GAS v4u*)(Qb + (size_t)(q0_ + 8 * j + (lane >> 3)) * CW + hq_ * 64 + 8 * (lane & 7)); } while (0)
    int U = F.vcu;
    if (U >= NUN) return;
    float sinkA = sinks[wave >> 1] * LOG2E, sinkB = sinks[4 + (wave >> 1)] * LOG2E;
    asm volatile("" : "+v"(sinkA), "+v"(sinkB));
    LAS unsigned char* Ksm = L; LAS unsigned char* Vsm = L + 32768;
    v4u kp[4], vp[4];
    ATT_KVLOAD(U);
    v4u qc[4], qn[4];
    ATT_QLOAD(qc, U, 0);
    ATT_KVWRITE;
    __syncthreads();
    v4u po[4]; int pq0 = 0, phq = 0;
#pragma unroll
    for (int i = 0; i < 4; ++i) po[i] = (v4u){0u, 0u, 0u, 0u};
    LAS unsigned char* Osm = L + 65536 + wave * 4608;
#pragma unroll 1
    for (int it = 0; ; ++it) {
        const int qs = it & 1;
        const int n = U & 15, kvh = (U >> 4) & 1, b = U >> 5; const int tb = b * SEQ + n * 128;
        if (qs == 0 && it > 0) { __syncthreads(); ATT_KVWRITE; __syncthreads(); }
        const bool last = (qs == 1) && (U + F.G >= NUN);
        const int hq = kvh * 4 + (wave >> 1); const float sink2 = kvh ? sinkB : sinkA;
        {
            const int qo = (wave & 1) * 64 + 32 * qs, q0 = tb + qo, ks0 = qo >> 5;
            bf16x8 qf[4];
#pragma unroll
            for (int j = 0; j < 4; ++j) *(LAS v4u*)(Osm + (8 * j + (lane >> 3)) * 144 + (lane & 7) * 16) = qc[j];
#pragma unroll
            for (int s = 0; s < 4; ++s) qf[s] = *(const LAS bf16x8*)(Osm + r * 144 + (2 * s + h) * 16);
            f32x16 st[5];
#pragma unroll
            for (int t5 = 0; t5 < 5; ++t5) { const int key = 32 * (ks0 + t5) + r; f32x16 a;
#pragma unroll
                for (int i = 0; i < 16; ++i) a[i] = 0.f;
#pragma unroll
                for (int s = 0; s < 4; ++s) { const bf16x8 kf = *(const LAS bf16x8*)(Ksm + key * 128 + (((2 * s + h) ^ ((key >> 1) & 7)) << 4));
                    a = __builtin_amdgcn_mfma_f32_32x32x16_bf16(kf, qf[s], a, 0, 0, 0); }
                st[t5] = a; }
            __builtin_amdgcn_sched_barrier(0);
            if (qs == 0) { const int Un = U + F.G; if (Un < NUN) ATT_KVLOAD(Un); }
            if (it > 0) {
#pragma unroll
                for (int j = 0; j < 4; ++j) *(v4u*)(Yatt + (size_t)(pq0 + 8 * j + (lane >> 3)) * DM + phq * 64 + 8 * (lane & 7)) = po[j]; }
            if (!last) { const int Ux = qs ? U + F.G : U; ATT_QLOAD(qn, Ux, qs ^ 1); }
            __builtin_amdgcn_sched_barrier(0);
            float mx = sink2;
#pragma unroll
            for (int t5 = 0; t5 < 5; ++t5) { const bool dead = (n == 0) && (ks0 + t5 < 4);
#pragma unroll
                for (int i = 0; i < 16; ++i) { const int krow = (i & 3) + 8 * (i >> 2) + 4 * h; bool vis = !dead;
                    if (t5 == 0) vis = vis && (krow >= r + 1); if (t5 == 4) vis = vis && (krow <= r);
                    const float v = vis ? st[t5][i] : -INFINITY; st[t5][i] = v; mx = fmaxf(mx, v); } }
            mx = fmaxf(mx, __shfl_xor(mx, 32));
            float l = 0.f;
#pragma unroll
            for (int t5 = 0; t5 < 5; ++t5)
#pragma unroll
                for (int i = 0; i < 16; ++i) { const float p = __builtin_amdgcn_exp2f(st[t5][i] - mx); st[t5][i] = p; l += p; }
            l += __shfl_xor(l, 32); l += __builtin_amdgcn_exp2f(sink2 - mx);
            f32x16 o[2];
#pragma unroll
            for (int i = 0; i < 16; ++i) { o[0][i] = 0.f; o[1][i] = 0.f; }
            const int li = lane & 15, qrow = li >> 2, p4 = li & 3;
#pragma unroll
            for (int t5 = 0; t5 < 5; ++t5)
#pragma unroll
                for (int s2 = 0; s2 < 2; ++s2) {
                    bf16x8 pf; { const unsigned w0 = cvt_pk(st[t5][8 * s2 + 0], st[t5][8 * s2 + 1]), w1 = cvt_pk(st[t5][8 * s2 + 2], st[t5][8 * s2 + 3]), w2 = cvt_pk(st[t5][8 * s2 + 4], st[t5][8 * s2 + 5]), w3 = cvt_pk(st[t5][8 * s2 + 6], st[t5][8 * s2 + 7]);
                        const v4u w = (v4u){w0, w1, w2, w3}; pf = __builtin_bit_cast(bf16x8, w); }
                    const int row0 = 32 * (ks0 + t5) + 16 * s2 + 4 * h + qrow;
#pragma unroll
                    for (int dt = 0; dt < 2; ++dt) { const int col = dt * 32 + 16 * ((lane >> 4) & 1) + 4 * p4;
                        const int off0 = row0 * 128 + ((((col >> 3) ^ (((row0 >> 1) & 1) << 2)) << 4) | (((col >> 2) & 1) << 3));
                        const s16x4 lo = __builtin_bit_cast(s16x4, __builtin_amdgcn_ds_read_tr16_b64_v4i16((LAS s16x4*)(Vsm + off0)));
                        const s16x4 hi = __builtin_bit_cast(s16x4, __builtin_amdgcn_ds_read_tr16_b64_v4i16((LAS s16x4*)(Vsm + off0 + 8 * 128)));
                        const bf16x8 vf = (bf16x8){lo[0], lo[1], lo[2], lo[3], hi[0], hi[1], hi[2], hi[3]};
                        o[dt] = __builtin_amdgcn_mfma_f32_32x32x16_bf16(vf, pf, o[dt], 0, 0, 0); } }
            const float inv = __builtin_amdgcn_rcpf(l);
#pragma unroll
            for (int dt = 0; dt < 2; ++dt)
#pragma unroll
                for (int g = 0; g < 4; ++g) *(LAS u32x2*)(Osm + r * 144 + (dt * 32 + 8 * g + 4 * h) * 2) = pack4((f32x4){o[dt][4 * g], o[dt][4 * g + 1], o[dt][4 * g + 2], o[dt][4 * g + 3]} * inv);
#pragma unroll
            for (int j = 0; j < 4; ++j) po[j] = *(const LAS v4u*)(Osm + (8 * j + (lane >> 3)) * 144 + (lane & 7) * 16);
            pq0 = q0; phq = hq;
        }
        if (last) break;
#pragma unroll
        for (int s = 0; s < 4; ++s) qc[s] = qn[s];
        if (qs == 1) U += F.G;
    }
#pragma unroll
    for (int j = 0; j < 4; ++j) *(v4u*)(Yatt + (size_t)(pq0 + 8 * j + (lane >> 3)) * DM + phq * 64 + 8 * (lane & 7)) = po[j];
    __syncthreads();
#undef ATT_KVLOAD
#undef ATT_KVWRITE
#undef ATT_QLOAD
}

#define DPPRED2(a, b) asm("s_nop 1\n\tv_add_f32_dpp %0, %0, %0 quad_perm:[1,0,3,2] row_mask:0xf bank_mask:0xf bound_ctrl:1\n\tv_add_f32_dpp %1, %1, %1 quad_perm:[1,0,3,2] row_mask:0xf bank_mask:0xf bound_ctrl:1\n\t" \
      "s_nop 0\n\tv_add_f32_dpp %0, %0, %0 quad_perm:[2,3,0,1] row_mask:0xf bank_mask:0xf bound_ctrl:1\n\tv_add_f32_dpp %1, %1, %1 quad_perm:[2,3,0,1] row_mask:0xf bank_mask:0xf bound_ctrl:1\n\t" \
      "s_nop 0\n\tv_add_f32_dpp %0, %0, %0 row_half_mirror row_mask:0xf bank_mask:0xf bound_ctrl:1\n\tv_add_f32_dpp %1, %1, %1 row_half_mirror row_mask:0xf bank_mask:0xf bound_ctrl:1\n\t" \
      "s_nop 0\n\tv_add_f32_dpp %0, %0, %0 row_mirror row_mask:0xf bank_mask:0xf bound_ctrl:1\n\tv_add_f32_dpp %1, %1, %1 row_mirror row_mask:0xf bank_mask:0xf bound_ctrl:1" : "+v"(a), "+v"(b))
#ifndef SCSKIP
#define SCSKIP 0
#endif
constexpr int SC_CH = 32, SC_NCH = SEQ / SC_CH;
constexpr int SC_ST = 0;
constexpr int SC_STB = 32768;
constexpr int SC_G = 65536;
constexpr int SC_KT = 73728, SC_RT = SC_KT + 4096, SC_KD = SC_RT + 4096, SC_BD = SC_KD + 4096;
constexpr int SC_KH = SC_BD + 4096, SC_BH = SC_KH + 4096, SC_VV = SC_BH + 4096, SC_UU = SC_VV + 4096;
constexpr int SC_HI = SC_UU + 4096;
constexpr int SC_XAK = SC_HI + 8192, SC_XPK = SC_XAK + 2048, SC_XPB = SC_XPK + 2048;
constexpr int SC_AB = SC_XPB + 2048;
constexpr int SC_RHS = SC_KT;
constexpr int SC_BON = SC_AB + 2048, SC_GC = SC_BON + 256, SC_LNW = SC_GC + 256, SC_LNB = SC_LNW + 256, SC_END = SC_LNB + 256;
static_assert(SC_END <= RING_BYTES, "scan LDS map");
__device__ __forceinline__ int imgA(int row, int c16) { return row * 128 + ((c16 ^ ((row >> 1) & 7)) << 4); }
__device__ __forceinline__ int imgT(int row, int col) { return row * 128 + ((((col >> 3) ^ (((row >> 1) & 1) << 2)) << 4) | (((col >> 2) & 1) << 3)); }
__device__ __forceinline__ int imgX(int t, int c16) { return t * 64 + ((c16 ^ ((t >> 2) & 3)) << 4); }
__device__ __forceinline__ bf16x8 fragA(LAS unsigned char* img, int row, int s, int h) { return *(const LAS bf16x8*)(img + imgA(row, 2 * s + h)); }
__device__ __forceinline__ bf16x8 fragX(LAS unsigned char* img, int t, int s, int h) { return *(const LAS bf16x8*)(img + imgX(t, 2 * s + h)); }
__device__ __forceinline__ bf16x8 fragT(LAS unsigned char* img, int s, int colbase, int lane) {
    const int li = lane & 15, row0 = 16 * s + 8 * (lane >> 5) + (li >> 2), col = colbase + 16 * ((lane >> 4) & 1) + 4 * (li & 3);
    LAS unsigned char* p = img + imgT(row0, col);
    const s16x4 lo = __builtin_bit_cast(s16x4, __builtin_amdgcn_ds_read_tr16_b64_v4i16((LAS s16x4*)p));
    const s16x4 hi = __builtin_bit_cast(s16x4, __builtin_amdgcn_ds_read_tr16_b64_v4i16((LAS s16x4*)(p + 4 * 128)));
    return (bf16x8){lo[0], lo[1], lo[2], lo[3], hi[0], hi[1], hi[2], hi[3]};
}
constexpr int SC_U32 = SC_KD, SC_YB = RING_BYTES + 6144;
static_assert(SC_YB + 8192 <= LDS_BYTES, "scan YB");
constexpr int SC_TINV = SC_END;
constexpr int SC_TOT = SC_TINV + 1024;
constexpr int SC_CST = SC_TOT + 2048;
constexpr int SC_END2 = SC_CST + 2048;
static_assert(SC_END2 <= RING_BYTES, "scan LDS map (2)");
constexpr int SC_XPB1 = SC_TINV;
constexpr int SC_KH1 = SC_ST + 20480, SC_BH1 = SC_STB + 20480, SC_VV1 = RING_BYTES + 1024, SC_RHSI = SC_YB;
static_assert(SC_VV1 + 4096 <= SC_YB, "scan VV1");
template <bool CHECK, int SKIP = SCSKIP> __device__ __forceinline__ void scan_phase_t(Frame& F) {
    LAS unsigned char* L = F.lds + RING_OFF;
    const int tid = fresh_tid(), lane = tid & 63, wave = F.wave, kg = tid & 15, rg = tid >> 4, r32 = lane & 31, h = lane >> 5;
#define Zsb WSP(bf16, WS_ZS)
#define Bbb WSP(bf16, WS_BB)
#define DEC WSP(bf16, WS_DEC)
#define Gg WSP(bf16, WS_GG)
#define Yrw (WSP(bf16, WS_Y2) + CW)
    const float* lnwp = INF(14); const float* lnbp = INF(15); const float* rkp = INF(13); const float* kap = INF(12); const float* mup = INF(5); const float* kkp = INF(11);
    for (int U = F.vcu; U < BATCH * 8; U += F.G) {
        const int b = U >> 3, hh = U & 7, cb = hh * 64; const size_t tok0 = (size_t)b * SEQ;
        if (tid < 64) { LAS float* cst = (LAS float*)(L + SC_CST); cst[384 + tid] = lnwp[cb + tid]; cst[448 + tid] = lnbp[cb + tid]; cst[tid] = mup[cb + tid]; cst[64 + tid] = mup[512 + cb + tid]; cst[128 + tid] = mup[1024 + cb + tid]; cst[192 + tid] = kkp[cb + tid]; cst[256 + tid] = kap[cb + tid]; cst[320 + tid] = rkp[cb + tid]; }
        for (int i = tid; i < 8192 / 4; i += NWAVES * 64) ((LAS unsigned*)(L + SC_HI))[i] = 0u;
        f32x16 HT;
        f32x16 NP, NPT, NTT;
#pragma unroll
        for (int i = 0; i < 16; ++i) { HT[i] = 0.f; NP[i] = 0.f; NPT[i] = 0.f; NTT[i] = 0.f; }
        v4u pre[3]; u32x2 predraw, vcur = (u32x2){0u, 0u}, gcur = vcur, vprev = vcur, gprev = vcur;
#define SC_ISSUE(c) do { _Pragma("unroll") for (int i = 0; i < 3; ++i) { const int q = tid + 512 * i; const int a = q >> 8, rem = q & 255, tk = rem >> 3, c8 = rem & 7; if (a < 5) { \
            const size_t tk_ = tok0 + (size_t)(c) * SC_CH + tk; \
            const bf16* src = (a < 3) ? (Zsb + tk_ * NSHIFT + a * 512 + cb + 8 * c8) : ((a == 3 ? Bbb : Gg) + tk_ * CW + cb + 8 * c8); pre[i] = *(const GAS v4u*)src; } } \
            predraw = *(const GAS u32x2*)(DEC + (tok0 + (size_t)(c) * SC_CH + rg) * CW + cb + 4 * kg); } while (0)
#define SC_WRITE(dst) do { _Pragma("unroll") for (int i = 0; i < 3; ++i) { const int q = tid + 512 * i; const int a = q >> 8, rem = q & 255, tk = rem >> 3, c8 = rem & 7; \
            if (a < 5) *(LAS v4u*)((dst) + a * 4096 + tk * 128 + c8 * 16) = pre[i]; } \
            *(LAS f32x4*)((dst) + 24576 + rg * 256 + kg * 16) = unpack4(predraw); } while (0)
#define SC_PREFIX(src, par) do { if (wave == 1 || wave == 2) { const int ch = (wave - 1) * 32 + r32; const LAS float* lam = (const LAS float*)((src) + 24576) + ch; LAS float* gout = (LAS float*)(Lc + SC_G) + ch; \
            float pa[16], run = 0.f; _Pragma("unroll") for (int j = 0; j < 16; ++j) { run += lam[(16 * h + j) * 64]; pa[j] = run; } \
            const float oth = __shfl_xor(run, 32), add = h ? oth : 0.f; \
            _Pragma("unroll") for (int j = 0; j < 16; ++j) gout[(16 * h + j) * 64] = pa[j] + add; \
            if (h) ((LAS float*)(Lc + SC_GC + 256 * (par)))[ch] = __expf(run + add); } } while (0)
#define SC_POST(cc, vv_, gg_) do { const size_t tok = tok0 + (size_t)(cc) * SC_CH + rg; \
              const f32x4 y = *(const LAS f32x4*)(Lc + SC_YB + rg * 256 + kg * 16); \
              float s = (y[0] + y[1]) + (y[2] + y[3]), q = (y[0] * y[0] + y[1] * y[1]) + (y[2] * y[2] + y[3] * y[3]); DPPRED2(s, q); \
              const float mean = s * (1.0f / 64.0f); const f32x4 dv = y - mean; \
              const float rs = __builtin_amdgcn_rsqf(fmaxf(q * (1.0f / 64.0f) - mean * mean, 0.f) + GN_EPS); \
              const f32x4 lnw = *(const LAS f32x4*)(Lc + SC_CST + 1536 + kg * 16), lnb = *(const LAS f32x4*)(Lc + SC_CST + 1792 + kg * 16); \
              const float bon = ((const LAS float*)(Lc + SC_BON + 128 * ((cc) & 1)))[rg]; \
              const f32x4 o = ((dv * rs) * lnw + lnb + unpack4(vv_) * bon) * unpack4(gg_); \
              if (CHECK) { const u32x2 nw = pack4(o), od = *(const u32x2*)(Yrw + tok * DM + cb + 4 * kg); if (nw.x != od.x || nw.y != od.y) WSP(unsigned, WS_CTL)[16] = 1u; } \
              else *(u32x2*)(Yrw + tok * DM + cb + 4 * kg) = pack4(o); } while (0)
#define ACCFRAG(X, s) __builtin_bit_cast(bf16x8, (v4u){cvt_pk(X[8 * (s)], X[8 * (s) + 1]), cvt_pk(X[8 * (s) + 2], X[8 * (s) + 3]), cvt_pk(X[8 * (s) + 4], X[8 * (s) + 5]), cvt_pk(X[8 * (s) + 6], X[8 * (s) + 7])})
#define ACCMM(D, W, X, C0) do { const bf16x8 w0_ = ACCFRAG(W, 0), w1_ = ACCFRAG(W, 1), x0_ = ACCFRAG(X, 0), x1_ = ACCFRAG(X, 1); \
            D = __builtin_amdgcn_mfma_f32_32x32x16_bf16(w0_, x0_, C0, 0, 0, 0); D = __builtin_amdgcn_mfma_f32_32x32x16_bf16(w1_, x1_, D, 0, 0, 0); } while (0)
#define NEU_STEP(last) do { f32x16 zero16_, q0_, q1_; _Pragma("unroll") for (int i = 0; i < 16; ++i) zero16_[i] = 0.f; \
            ACCMM(q0_, NPT, NP, zero16_); if (!(last)) { ACCMM(q1_, NP, NPT, zero16_); NPT = q1_; } NP = q0_; ACCMM(q1_, NP, NTT, NTT); NTT = q1_; } while (0)
        SC_ISSUE(0); SC_WRITE(L + SC_ST); SC_ISSUE(1);
        __syncthreads();
        { LAS unsigned char* Lc = L; asm volatile("" : "+v"(Lc)); SC_PREFIX(Lc + SC_ST, 0); }
        __syncthreads();
#pragma unroll 1
        for (int c = -1; c < SC_NCH; ++c) {
            LAS unsigned char* Lc = L; asm volatile("" : "+v"(Lc));
            const int p = c & 1;
            LAS unsigned char* stc = Lc + (p ? SC_STB : SC_ST); LAS unsigned char* stq = Lc + (p ? SC_ST : SC_STB);
            LAS unsigned char* ikh = Lc + (p ? SC_KH1 : SC_KH); LAS unsigned char* ibh = Lc + (p ? SC_BH1 : SC_BH); LAS unsigned char* ivv = Lc + (p ? SC_VV1 : SC_VV);
            f32x16 acc;
            if (c >= 0) {
                if (wave < 4 && !(SKIP & 8) && c > 0) { SC_POST(c - 1, vprev, gprev); }
                if (SKIP & 2) { if (wave >= 4) { _Pragma("unroll") for (int i = 0; i < 16; ++i) acc[i] = 0.f; } } else
                if (wave == 0) { if (!(SKIP & 32)) {
                    NEU_STEP(false); NEU_STEP(true); }
#pragma unroll
                    for (int g = 0; g < 4; ++g) *(LAS u32x2*)(Lc + SC_AB + imgX(r32, g) + 8 * h) = pack4((f32x4){NTT[4 * g], NTT[4 * g + 1], NTT[4 * g + 2], NTT[4 * g + 3]});
                } else if (wave >= 4) { const int vt = wave & 1; LAS unsigned char* ib = Lc + (wave < 6 ? SC_KT : SC_RT);
#pragma unroll
                    for (int i = 0; i < 16; ++i) acc[i] = 0.f;
#pragma unroll
                    for (int s = 0; s < 4; ++s) acc = __builtin_amdgcn_mfma_f32_32x32x16_bf16(fragT(Lc + SC_HI, s, vt * 32, lane), fragA(ib, r32, s, h), acc, 0, 0, 0);
                    LAS unsigned char* xi = Lc + (wave < 6 ? SC_XAK : SC_XPK);
#pragma unroll
                    for (int s = 0; s < 2; ++s) acc = __builtin_amdgcn_mfma_f32_32x32x16_bf16(fragT(ivv, s, vt * 32, lane), fragX(xi, r32, s, h), acc, 0, 0, 0);
                    if (wave < 6) {
#pragma unroll
                        for (int g = 0; g < 4; ++g) *(LAS u32x2*)(Lc + SC_UU + imgT(r32, vt * 32 + 8 * g + 4 * h)) = pack4((f32x4){acc[4 * g], acc[4 * g + 1], acc[4 * g + 2], acc[4 * g + 3]}); }
                }
                if (wave >= 4 && !(SKIP & 8) && c > 0) { SC_POST(c - 1, vprev, gprev); }
                if (c + 1 < SC_NCH) SC_PREFIX(stq, (c + 1) & 1);
                __syncthreads();
            }
            if (!(SKIP & 4) && c >= 0 && (wave == 4 || wave == 5)) { const int vt = wave & 1; f32x16 u;
#pragma unroll
                for (int i = 0; i < 16; ++i) u[i] = 0.f;
#pragma unroll
                for (int s = 0; s < 2; ++s) u = __builtin_amdgcn_mfma_f32_32x32x16_bf16(fragT(Lc + SC_UU, s, vt * 32, lane), fragX(Lc + SC_AB, r32, s, h), u, 0, 0, 0);
#pragma unroll
                for (int g = 0; g < 4; ++g) *(LAS u32x2*)(Lc + SC_UU + imgT(r32, vt * 32 + 8 * g + 4 * h)) = pack4((f32x4){u[4 * g], u[4 * g + 1], u[4 * g + 2], u[4 * g + 3]}); }
            if (!(SKIP & 1) && c + 1 < SC_NCH) {
              __builtin_amdgcn_sched_barrier(0);
              const int t = rg, c4 = 4 * kg;
              const f32x4 g = *(const LAS f32x4*)(Lc + SC_G + t * 256 + c4 * 4), gcv = *(const LAS f32x4*)(Lc + SC_GC + 256 * (1 - p) + c4 * 4);
              const f32x4 gp = g - *(const LAS f32x4*)(stq + 24576 + t * 256 + c4 * 4);
              const f32x4 mur = *(const LAS f32x4*)(Lc + SC_CST + c4 * 4), muk = *(const LAS f32x4*)(Lc + SC_CST + 256 + c4 * 4), muv = *(const LAS f32x4*)(Lc + SC_CST + 512 + c4 * 4);
              const f32x4 kkc = *(const LAS f32x4*)(Lc + SC_CST + 768 + c4 * 4), kac = *(const LAS f32x4*)(Lc + SC_CST + 1024 + c4 * 4), rkc = *(const LAS f32x4*)(Lc + SC_CST + 1280 + c4 * 4);
              const LAS unsigned char* pr = (t > 0) ? (stq + (t - 1) * 128) : (stc + 31 * 128); const bool hp = (t > 0 || c >= 0);
              const f32x4 r0 = unpack4(*(const LAS u32x2*)(stq + 0 * 4096 + t * 128 + c4 * 2)), k0 = unpack4(*(const LAS u32x2*)(stq + 1 * 4096 + t * 128 + c4 * 2)), v0 = unpack4(*(const LAS u32x2*)(stq + 2 * 4096 + t * 128 + c4 * 2));
              const f32x4 zero4 = (f32x4){0.f, 0.f, 0.f, 0.f};
              const f32x4 r1 = hp ? unpack4(*(const LAS u32x2*)(pr + 0 * 4096 + c4 * 2)) : zero4, k1 = hp ? unpack4(*(const LAS u32x2*)(pr + 1 * 4096 + c4 * 2)) : zero4, v1 = hp ? unpack4(*(const LAS u32x2*)(pr + 2 * 4096 + c4 * 2)) : zero4;
              const f32x4 rr = r0 + (r1 - r0) * mur, vsh = v0 + (v1 - v0) * muv; f32x4 kk = k0 + (k1 - k0) * muk;
              const f32x4 aa = unpack4(*(const LAS u32x2*)(stq + 3 * 4096 + t * 128 + c4 * 2));
              vprev = vcur; gprev = gcur; gcur = *(const LAS u32x2*)(stq + 4 * 4096 + t * 128 + c4 * 2);
              f32x4 ka = kk * kkc; float ss = (ka[0] * ka[0] + ka[1] * ka[1]) + (ka[2] * ka[2] + ka[3] * ka[3]);
              kk = kk * ((aa - 1.0f) * kac + 1.0f);
              float rk = (rr[0] * kk[0] * rkc[0] + rr[1] * kk[1] * rkc[1]) + (rr[2] * kk[2] * rkc[2] + rr[3] * kk[3] * rkc[3]);
              DPPRED2(ss, rk);
              ka = ka * fminf(__builtin_amdgcn_rsqf(ss), 1e12f);
              const f32x4 bb = ka * aa;
              vcur = pack4(vsh);
              f32x4 eg, egp, eng;
#pragma unroll
              for (int j = 0; j < 4; ++j) { eg[j] = __expf(g[j]); egp[j] = __expf(gp[j]); eng[j] = __builtin_amdgcn_rcpf(eg[j]); }
              const f32x4 egl = gcv * eng;
              const int oa = imgA(t, c4 >> 3) + (c4 & 7) * 2, ot = imgT(t, c4);
              *(LAS u32x2*)(Lc + SC_KT + oa) = pack4(ka * egp); *(LAS u32x2*)(Lc + SC_RT + oa) = pack4(rr * eg);
              *(LAS u32x2*)(Lc + SC_KD + oa) = pack4(kk * eng); *(LAS u32x2*)(Lc + SC_BD + oa) = pack4(bb * eng);
              *(LAS u32x2*)(Lc + (p ? SC_KH : SC_KH1) + ot) = pack4(kk * egl); *(LAS u32x2*)(Lc + (p ? SC_BH : SC_BH1) + ot) = pack4(bb * egl * -1.0f);
              *(LAS u32x2*)(Lc + (p ? SC_VV : SC_VV1) + ot) = vcur;
              if (kg == 0) ((LAS float*)(Lc + SC_BON + 128 * (1 - p)))[t] = rk;
            }
            __syncthreads();
            asm volatile("" : "=v"(NP), "=v"(NPT), "=v"(NTT));
            if (!(SKIP & 16) && c >= 0 && wave >= 4) { const int vt = wave & 1, kt = (wave >> 1) & 1;
                if (wave >= 6) {
#pragma unroll
                    for (int s = 0; s < 2; ++s) acc = __builtin_amdgcn_mfma_f32_32x32x16_bf16(fragT(Lc + SC_UU, s, vt * 32, lane), fragX(Lc + (p ? SC_XPB1 : SC_XPB), r32, s, h), acc, 0, 0, 0);
#pragma unroll
                    for (int g = 0; g < 4; ++g) *(LAS f32x4*)(Lc + SC_YB + r32 * 256 + (vt * 32 + 8 * g + 4 * h) * 4) = (f32x4){acc[4 * g], acc[4 * g + 1], acc[4 * g + 2], acc[4 * g + 3]}; }
                const float gc = ((const LAS float*)(Lc + SC_GC + 256 * p))[kt * 32 + r32];
#pragma unroll
                for (int i = 0; i < 16; ++i) HT[i] *= gc;
#pragma unroll
                for (int s = 0; s < 2; ++s) { HT = __builtin_amdgcn_mfma_f32_32x32x16_bf16(fragT(ivv, s, vt * 32, lane), fragT(ikh, s, kt * 32, lane), HT, 0, 0, 0);
                    HT = __builtin_amdgcn_mfma_f32_32x32x16_bf16(fragT(Lc + SC_UU, s, vt * 32, lane), fragT(ibh, s, kt * 32, lane), HT, 0, 0, 0); }
                const int k = kt * 32 + r32;
#pragma unroll
                for (int g = 0; g < 4; ++g) *(LAS u32x2*)(Lc + SC_HI + imgT(k, vt * 32 + 8 * g + 4 * h)) = pack4((f32x4){HT[4 * g], HT[4 * g + 1], HT[4 * g + 2], HT[4 * g + 3]});
            }
            if (!(SKIP & 32) && c + 1 < SC_NCH && wave == 0) {
                bf16x8 fk[4], fb[4];
#pragma unroll
                for (int s = 0; s < 4; ++s) { fk[s] = fragA(Lc + SC_KT, r32, s, h); fb[s] = fragA(Lc + SC_BD, r32, s, h); }
                f32x16 x, y;
#pragma unroll
                for (int i = 0; i < 16; ++i) { x[i] = 0.f; y[i] = 0.f; }
#pragma unroll
                for (int s = 0; s < 4; ++s) { x = __builtin_amdgcn_mfma_f32_32x32x16_bf16(fb[s], fk[s], x, 0, 0, 0); y = __builtin_amdgcn_mfma_f32_32x32x16_bf16(fk[s], fb[s], y, 0, 0, 0); }
                int tm = r32 - 4 * h; asm volatile("" : "+v"(tm));
#pragma unroll
                for (int i = 0; i < 16; ++i) { const int ci = (i & 3) + 8 * (i >> 2); NPT[i] = (ci < tm) ? x[i] : 0.f; NP[i] = (ci > tm) ? y[i] : 0.f; NTT[i] = ((ci == tm) ? 1.0f : 0.0f) - NPT[i]; }
                NEU_STEP(false); NEU_STEP(false);
            }
            if (!(SKIP & 2) && c + 1 < SC_NCH && wave >= 1 && wave < 4) {
                LAS unsigned char* ia = Lc + ((wave == 3) ? SC_BD : SC_KD); LAS unsigned char* ib = Lc + ((wave < 2) ? SC_KT : SC_RT);
                f32x16 x;
#pragma unroll
                for (int i = 0; i < 16; ++i) x[i] = 0.f;
#pragma unroll
                for (int s = 0; s < 4; ++s) x = __builtin_amdgcn_mfma_f32_32x32x16_bf16(fragA(ia, r32, s, h), fragA(ib, r32, s, h), x, 0, 0, 0);
                int tm = r32 - 4 * h; asm volatile("" : "+v"(tm));
#pragma unroll
                for (int i = 0; i < 16; ++i) { const int ci = (i & 3) + 8 * (i >> 2); const bool keep = (wave < 2) ? (ci < tm) : (ci <= tm); float v = keep ? x[i] : 0.f; if (wave == 3) v = -v; x[i] = v; }
                LAS unsigned char* xo = Lc + (wave == 1 ? SC_XAK : wave == 2 ? SC_XPK : (p ? SC_XPB : SC_XPB1));
#pragma unroll
                for (int g = 0; g < 4; ++g) *(LAS u32x2*)(xo + imgX(r32, g) + 8 * h) = pack4((f32x4){x[4 * g], x[4 * g + 1], x[4 * g + 2], x[4 * g + 3]});
            }
            if (!(SKIP & 64) && c + 2 < SC_NCH) { SC_WRITE(stc); if (c + 3 < SC_NCH) SC_ISSUE(c + 3); }
            __syncthreads();
        }
        { LAS unsigned char* Lc = L; asm volatile("" : "+v"(Lc)); SC_POST(SC_NCH - 1, vcur, gcur); }
        __syncthreads();
#undef NEU_STEP
#undef ACCMM
#undef ACCFRAG
#undef SC_POST
#undef Zsb
#undef Bbb
#undef DEC
#undef Gg
#undef Yrw
#undef SC_ISSUE
#undef SC_WRITE
#undef SC_PREFIX
    }
}

__device__ __forceinline__ void scan_phase(Frame& F) { scan_phase_t<false>(F); }

__device__ __forceinline__ void route_tile(Frame& F, int pm) {
    LAS unsigned* hist = (LAS unsigned*)(F.lds + RING_OFF);
    const int tid = fresh_tid();
    if (tid < 32) hist[tid] = 0u;
    __syncthreads();
    if (tid < 256) {
        const int t = pm * 256 + tid; const float* lg = WSP(float, WS_LOG) + (size_t)t * 64;
        const f32x4 g4 = *(const GAS f32x4*)lg;
        int gi = 0; float gm = g4[0];
        if (g4[1] > gm) { gm = g4[1]; gi = 1; } if (g4[2] > gm) { gm = g4[2]; gi = 2; } if (g4[3] > gm) { gm = g4[3]; gi = 3; }
        const float gden = (__expf(g4[0] - gm) + __expf(g4[1] - gm)) + (__expf(g4[2] - gm) + __expf(g4[3] - gm));
        const float gw = 1.0f / gden;
        const f32x4 e0 = *(const GAS f32x4*)(lg + 4 + gi * 8), e1 = *(const GAS f32x4*)(lg + 8 + gi * 8);
        float ev[8] = {e0[0], e0[1], e0[2], e0[3], e1[0], e1[1], e1[2], e1[3]};
        int i1 = 0; float m1 = ev[0];
#pragma unroll
        for (int j = 1; j < 8; ++j) if (ev[j] > m1) { m1 = ev[j]; i1 = j; }
        int i2 = -1; float m2 = -INFINITY;
#pragma unroll
        for (int j = 0; j < 8; ++j) if (j != i1 && ev[j] > m2) { m2 = ev[j]; i2 = j; }
        const float ex = __expf(m2 - m1); const float w1 = 1.0f / (1.0f + ex), w2 = ex * w1;
        const int x1 = gi * 8 + i1, x2 = gi * 8 + i2;
        const unsigned r1 = __hip_atomic_fetch_add(hist + x1, 1u, __ATOMIC_RELAXED, __HIP_MEMORY_SCOPE_WORKGROUP);
        const unsigned r2 = __hip_atomic_fetch_add(hist + x2, 1u, __ATOMIC_RELAXED, __HIP_MEMORY_SCOPE_WORKGROUP);
        typedef int i32x2 __attribute__((ext_vector_type(2)));
        *(i32x2*)(WSP(int, WS_RT_E) + 2 * t) = (i32x2){x1, x2};
        *(f32x2*)(WSP(float, WS_RT_W) + 2 * t) = (f32x2){gw * w1, gw * w2};
        *(i32x2*)(WSP(int, WS_RT_RANK) + 2 * t) = (i32x2){(int)r1, (int)r2};
    }
    __syncthreads();
    if (tid < 32) WSP(int, WS_TABLE)[pm * 32 + tid] = (int)hist[tid];
    __syncthreads();
}

__device__ __forceinline__ void gather_phase(Frame& F) {
    LAS int* tab = (LAS int*)(F.lds + RING_OFF);
    LAS int* pstart = tab + 256 * 32;
    LAS int* base = pstart + 64;
    const int tid = fresh_tid(), lane = tid & 63, wave = F.wave;
    for (int i = tid; i < 256 * 32; i += NWAVES * 64) tab[i] = WSP(int, WS_TABLE)[i];
    __syncthreads();
    if (tid < 32) { int s = 0; for (int pm = 0; pm < 256; ++pm) s += tab[pm * 32 + tid]; base[tid] = (s + 255) & ~255; }
    __syncthreads();
    if (tid == 0) { int s = 0; for (int e = 0; e < NEXP; ++e) { pstart[e] = s; s += base[e]; } pstart[NEXP] = s; }
    __syncthreads();
    if (F.vcu == 0) {
        int* meta = WSP(int, WS_META); const int nrt = pstart[NEXP] >> 8;
        if (tid == 0) meta[0] = nrt;
        if (tid < 33) meta[1 + tid] = pstart[tid];
        for (int rt = tid; rt < nrt; rt += NWAVES * 64) { int e = 0;
            for (int j = 1; j < NEXP; ++j) if ((rt << 8) >= pstart[j]) e = j;
            meta[64 + rt] = e; }
    }
    for (int pm = F.vcu; pm < T / 256; pm += F.G) {
        __syncthreads();
        if (tid < 32) { int s = pstart[tid]; for (int q = 0; q < pm; ++q) s += tab[q * 32 + tid]; base[tid] = s; }
        __syncthreads();
        { const int t = pm * 256 + (tid >> 1), k = tid & 1; const int e = WSP(int, WS_RT_E)[2 * t + k], rk = WSP(int, WS_RT_RANK)[2 * t + k];
            const int pos = base[e] + rk; WSP(int, WS_RT_POS)[2 * t + k] = pos; WSP(float, WS_ROWSCALE)[pos] = WSP(float, WS_RSTD2)[t]; WSP(int, WS_ROWTOK)[pos] = t; }
    }
}

__device__ __forceinline__ void combine_phase(Frame& F, int pm) {
    const int lane = fresh_tid() & 63;
    constexpr int NT = 4;
    for (int t0 = 256 * pm + NT * F.wave; t0 < 256 * pm + 256; t0 += NT * NWAVES) {
        v4u a[NT][2], b0[NT][2], b1[NT][2]; float w0[NT], w1[NT];
#pragma unroll
        for (int q = 0; q < NT; ++q) { const int t = t0 + q; const int p0 = WSP(int, WS_RT_POS)[2 * t], p1 = WSP(int, WS_RT_POS)[2 * t + 1]; w0[q] = WSP(float, WS_RT_W)[2 * t]; w1[q] = WSP(float, WS_RT_W)[2 * t + 1];
            const GAS v4u* xb = (const GAS v4u*)(WSP(bf16, WS_XB) + (size_t)t * DM) + lane;
            const GAS v4u* y0 = (const GAS v4u*)(WSP(bf16, WS_Y) + (size_t)p0 * DM) + lane; const GAS v4u* y1 = (const GAS v4u*)(WSP(bf16, WS_Y) + (size_t)p1 * DM) + lane;
#pragma unroll
            for (int j = 0; j < 2; ++j) { a[q][j] = xb[64 * j]; b0[q][j] = y0[64 * j]; b1[q][j] = y1[64 * j]; } }
        float s[NT];
#pragma unroll
        for (int q = 0; q < NT; ++q) { const int t = t0 + q; GAS v4u* xb = (GAS v4u*)(WSP(bf16, WS_XB) + (size_t)t * DM) + lane; s[q] = 0.f;
#pragma unroll
            for (int j = 0; j < 2; ++j) { v4u o;
#pragma unroll
                for (int i = 0; i < 4; ++i) { const unsigned aw = a[q][j][i], bw0 = b0[q][j][i], bw1 = b1[q][j][i];
                    const float lo = bflo(aw) + (bflo(bw0) * w0[q] + bflo(bw1) * w1[q]), hi = bfhi(aw) + (bfhi(bw0) * w0[q] + bfhi(bw1) * w1[q]);
                    s[q] += lo * lo + hi * hi; o[i] = cvt_pk(lo, hi); }
                xb[64 * j] = o; } }
#pragma unroll
        for (int o = 1; o < 64; o <<= 1) {
#pragma unroll
            for (int q = 0; q < NT; ++q) s[q] += __shfl_xor(s[q], o); }
        { float sv = s[0]; if (lane == 1) sv = s[1]; asm volatile("" : "+v"(sv)); if (lane == 2) sv = s[2]; asm volatile("" : "+v"(sv)); if (lane == 3) sv = s[3];
          if (lane < 4) WSP(float, WS_RSTD3)[t0 + lane] = 1.0f / sqrtf(sv * (1.0f / DM) + NORM_EPS); }
    }
}

__device__ __forceinline__ void final_phase(Frame& F, int pm) {
    const int lane = fresh_tid() & 63;
    const GAS f32x4* gn = (const GAS f32x4*)INF(31) + lane; f32x4 g[4];
#pragma unroll
    for (int j = 0; j < 4; ++j) g[j] = gn[64 * j];
    const float chkmul = (WSP(unsigned, WS_CTL)[16] != 0u) ? __builtin_nanf("") : 1.0f;
    constexpr int NT = 8;
    for (int t0 = 256 * pm + NT * F.wave; t0 < 256 * pm + 256; t0 += NT * NWAVES) {
        u32x2 v[NT][4]; float sp[NT];
#pragma unroll
        for (int q = 0; q < NT; ++q) { const GAS u32x2* x = (const GAS u32x2*)(WSP(bf16, WS_X3B) + (size_t)(t0 + q) * DM) + lane; sp[q] = WSP(float, WS_SSQ4)[(size_t)(lane & 15) * T + t0 + q];
#pragma unroll
            for (int j = 0; j < 4; ++j) v[q][j] = x[64 * j]; }
#pragma unroll
        for (int q = 0; q < NT; ++q) { float s = sp[q]; s += __shfl_xor(s, 1); s += __shfl_xor(s, 2); s += __shfl_xor(s, 4); s += __shfl_xor(s, 8);
            const float rs = 1.0f / sqrtf(s * (1.0f / DM) + NORM_EPS) * chkmul;
            GAS f32x4* o = (GAS f32x4*)(F.out + (size_t)(t0 + q) * DM) + lane;
#pragma unroll
            for (int j = 0; j < 4; ++j) o[64 * j] = unpack4(v[q][j]) * rs * g[j]; }
    }
}
#define DPPRED2_SEQ(a, b) asm("s_nop 1\n\tv_add_f32_dpp %0, %0, %0 quad_perm:[1,0,3,2] row_mask:0xf bank_mask:0xf bound_ctrl:1\n\tv_add_f32_dpp %1, %1, %1 quad_perm:[1,0,3,2] row_mask:0xf bank_mask:0xf bound_ctrl:1\n\t" \
      "s_nop 0\n\tv_add_f32_dpp %0, %0, %0 quad_perm:[2,3,0,1] row_mask:0xf bank_mask:0xf bound_ctrl:1\n\tv_add_f32_dpp %1, %1, %1 quad_perm:[2,3,0,1] row_mask:0xf bank_mask:0xf bound_ctrl:1\n\t" \
      "s_nop 0\n\tv_add_f32_dpp %0, %0, %0 row_half_mirror row_mask:0xf bank_mask:0xf bound_ctrl:1\n\tv_add_f32_dpp %1, %1, %1 row_half_mirror row_mask:0xf bank_mask:0xf bound_ctrl:1\n\t" \
      "s_nop 0\n\tv_add_f32_dpp %0, %0, %0 row_mirror row_mask:0xf bank_mask:0xf bound_ctrl:1\n\tv_add_f32_dpp %1, %1, %1 row_mirror row_mask:0xf bank_mask:0xf bound_ctrl:1" : "+v"(a), "+v"(b))
constexpr int SQ_CH = 32, SQ_NCH = SEQ / SQ_CH, SQ_A = SQ_CH * 64;
struct ScanOps { f32x4 r4, k4, kk4, b4, w4; f32x2 v2; };
__device__ __forceinline__ void scan_load(ScanOps& o, const LAS float* cur, int t, int kg, int rg) {
    o.r4 = *(const LAS f32x4*)(cur + 0 * SQ_A + t * 64 + 4 * kg); o.k4 = *(const LAS f32x4*)(cur + 1 * SQ_A + t * 64 + 4 * kg);
    o.kk4 = *(const LAS f32x4*)(cur + 3 * SQ_A + t * 64 + 4 * kg); o.b4 = *(const LAS f32x4*)(cur + 4 * SQ_A + t * 64 + 4 * kg);
    o.w4 = *(const LAS f32x4*)(cur + 5 * SQ_A + t * 64 + 4 * kg); o.v2 = *(const LAS f32x2*)(cur + 2 * SQ_A + t * 64 + 2 * rg);
}
__device__ __forceinline__ float mul_s(float a, float b) { float r; asm("v_mul_f32_e32 %0, %1, %2" : "=v"(r) : "v"(a), "v"(b)); return r; }
__device__ __forceinline__ float fmac_s(float acc, float a, float b) { asm("v_fmac_f32_e32 %0, %1, %2" : "+v"(acc) : "v"(a), "v"(b)); return acc; }
__device__ __forceinline__ void scan_step(float (&S0)[4], float (&S1)[4], const ScanOps& o, LAS float* yout) {
    float d0 = mul_s(S0[0], o.kk4[0]), d1 = mul_s(S1[0], o.kk4[0]);
    d0 = fmac_s(d0, S0[1], o.kk4[1]); d1 = fmac_s(d1, S1[1], o.kk4[1]);
    d0 = fmac_s(d0, S0[2], o.kk4[2]); d1 = fmac_s(d1, S1[2], o.kk4[2]);
    d0 = fmac_s(d0, S0[3], o.kk4[3]); d1 = fmac_s(d1, S1[3], o.kk4[3]);
    DPPRED2_SEQ(d0, d1);
#pragma unroll
    for (int i = 0; i < 4; ++i) {
        float t0 = mul_s(o.v2[0], o.k4[i]), t1 = mul_s(o.v2[1], o.k4[i]);
        t0 = fmac_s(t0, d0, o.b4[i]); t1 = fmac_s(t1, d1, o.b4[i]);
        S0[i] = fmac_s(t0, S0[i], o.w4[i]); S1[i] = fmac_s(t1, S1[i], o.w4[i]); }
    float y0 = mul_s(S0[0], o.r4[0]), y1 = mul_s(S1[0], o.r4[0]);
    y0 = fmac_s(y0, S0[1], o.r4[1]); y1 = fmac_s(y1, S1[1], o.r4[1]);
    y0 = fmac_s(y0, S0[2], o.r4[2]); y1 = fmac_s(y1, S1[2], o.r4[2]);
    y0 = fmac_s(y0, S0[3], o.r4[3]); y1 = fmac_s(y1, S1[3], o.r4[3]);
    DPPRED2_SEQ(y0, y1);
    *(LAS f32x2*)yout = (f32x2){y0, y1};
}
__device__ __forceinline__ float red16f(float x) { float z = 0.f; DPPRED2_SEQ(x, z); return x; }
__device__ __forceinline__ void scan_phase_seq(Frame& F) {
    LAS float* buf0 = (LAS float*)(F.lds + RING_OFF); LAS float* buf1 = buf0 + 6 * SQ_A; LAS float* ybuf = buf1 + 6 * SQ_A;
    const int tid = fresh_tid(), kg = tid & 15, rg = tid >> 4;
    const bf16* Rb = WSP(bf16, WS_R); const bf16* Krb = WSP(bf16, WS_KR); const bf16* Vrb = WSP(bf16, WS_VR); const bf16* KKb = WSP(bf16, WS_KK); const bf16* Bbb = WSP(bf16, WS_BB);
    const float* DEC = WSP(float, WS_DEC); const bf16* Gg = WSP(bf16, WS_GG); bf16* Yrw = WSP(bf16, WS_Y2);
    for (int U = F.vcu; U < BATCH * 8; U += F.G) {
        const int b = U >> 3, hh = U & 7, cb = hh * 64; const size_t tok0 = (size_t)b * SEQ;
        float S0[4] = {0.f, 0.f, 0.f, 0.f}, S1[4] = {0.f, 0.f, 0.f, 0.f};
        const f32x4 lnw = *(const f32x4*)(INF(14) + cb + 4 * kg), lnb = *(const f32x4*)(INF(15) + cb + 4 * kg), rkc = *(const f32x4*)(INF(13) + cb + 4 * kg);
        v4u pre[3]; f32x4 pred; u32x2 ggn, ggc;
#define SQ_ISSUE(c) do { _Pragma("unroll") for (int i = 0; i < 3; ++i) { const int q = tid + 512 * i; if (q < 1280) { const int a = q >> 8, rem = q & 255, tk = rem >> 3, c8 = rem & 7; \
            const bf16* src = (a == 0 ? Rb : a == 1 ? Krb : a == 2 ? Vrb : a == 3 ? KKb : Bbb) + (tok0 + (size_t)(c) * SQ_CH + tk) * CW + cb + 8 * c8; pre[i] = *(const GAS v4u*)src; } } \
            pred = *(const GAS f32x4*)(DEC + (tok0 + (size_t)(c) * SQ_CH + rg) * CW + cb + 4 * kg); \
            ggn = *(const GAS u32x2*)(Gg + (tok0 + (size_t)(c) * SQ_CH + rg) * CW + cb + 4 * kg); } while (0)
#define SQ_WRITE(dst) do { _Pragma("unroll") for (int i = 0; i < 3; ++i) { const int q = tid + 512 * i; if (q < 1280) { const int a = q >> 8, rem = q & 255, tk = rem >> 3, c8 = rem & 7; \
            LAS float* d = (dst) + a * SQ_A + tk * 64 + 8 * c8; const v4u w = pre[i]; \
            const float sg = (a == 4) ? -1.0f : 1.0f;   \
            *(LAS f32x4*)d = (f32x4){bflo(w.x), bfhi(w.x), bflo(w.y), bfhi(w.y)} * sg; *(LAS f32x4*)(d + 4) = (f32x4){bflo(w.z), bfhi(w.z), bflo(w.w), bfhi(w.w)} * sg; } } \
            *(LAS f32x4*)((dst) + 5 * SQ_A + rg * 64 + 4 * kg) = (f32x4){__expf(pred[0]), __expf(pred[1]), __expf(pred[2]), __expf(pred[3])}; } while (0)
        LAS float* const ywr = (kg == 0) ? (ybuf + 2 * rg) : (ybuf + SQ_A + 2 * tid); const int ystep = (kg == 0) ? 64 : 0;
        SQ_ISSUE(0); SQ_WRITE(buf0); ggc = ggn;
        __syncthreads();
#pragma unroll 1
        for (int c = 0; c < SQ_NCH; ++c) {
            LAS float* cur = (c & 1) ? buf1 : buf0; LAS float* nxt = (c & 1) ? buf0 : buf1;
            if (c + 1 < SQ_NCH) SQ_ISSUE(c + 1);
            ScanOps oa, ob; scan_load(oa, cur, 0, kg, rg);
#pragma unroll 1
            for (int t = 0; t < SQ_CH; t += 2) {
                scan_load(ob, cur, t + 1, kg, rg);
                scan_step(S0, S1, oa, ywr + t * ystep);
                scan_load(oa, cur, (t + 2) & (SQ_CH - 1), kg, rg);
                scan_step(S0, S1, ob, ywr + (t + 1) * ystep);
            }
            __syncthreads();
            { const int t = rg; const size_t tok = tok0 + (size_t)c * SQ_CH + t;
              const f32x4 y = *(const LAS f32x4*)(ybuf + t * 64 + 4 * kg);
              const f32x4 r4 = *(const LAS f32x4*)(cur + 0 * SQ_A + t * 64 + 4 * kg), k4 = *(const LAS f32x4*)(cur + 1 * SQ_A + t * 64 + 4 * kg), v4 = *(const LAS f32x4*)(cur + 2 * SQ_A + t * 64 + 4 * kg);
              float s = (y[0] + y[1]) + (y[2] + y[3]); float rk = (r4[0] * k4[0] * rkc[0] + r4[1] * k4[1] * rkc[1]) + (r4[2] * k4[2] * rkc[2] + r4[3] * k4[3] * rkc[3]);
              DPPRED2_SEQ(s, rk);
              const float mean = s * (1.0f / 64.0f); const f32x4 dv = y - mean; float q = (dv[0] * dv[0] + dv[1] * dv[1]) + (dv[2] * dv[2] + dv[3] * dv[3]);
              q = red16f(q);
              const float rs = 1.0f / sqrtf(q * (1.0f / 64.0f) + GN_EPS); const f32x4 g = unpack4(ggc);
              const f32x4 o = ((dv * rs) * lnw + lnb + v4 * rk) * g;
              *(u32x2*)(Yrw + tok * CW + cb + 4 * kg) = pack4(o); }
            if (c + 1 < SQ_NCH) { SQ_WRITE(nxt); ggc = ggn; }
            __syncthreads();
        }
#undef SQ_ISSUE
#undef SQ_WRITE
    }
}


#ifndef PG_ALIGN
#define PG_ALIGN true
#endif
#ifndef PG_SP2
#define PG_SP2 true
#endif
constexpr int NPH = 14;
struct Args { const void* in[32]; float* out; unsigned char* ws; int ph_lo, ph_hi; };
__global__ void __launch_bounds__(NWAVES * 64, 2) fwd_kernel(Args args) {
    extern __shared__ __attribute__((aligned(16))) unsigned char lds[];
    Frame F;
    F.lds = (LAS unsigned char*)lds;
    F.MISC = (volatile LAS unsigned*)(F.lds + MISC_OFF);
    F.wave = __builtin_amdgcn_readfirstlane((int)threadIdx.x >> 6);
    F.G = gridDim.x; { const int bx = blockIdx.x; F.vcu = (F.G % 8 == 0) ? (bx % 8) * (F.G / 8) + bx / 8 : bx; }
    F.ws = args.ws; F.out = args.out;
    F.ctl = (gu32*)(args.ws + WS_CTL);
    for (int u = fresh_tid(); u < (LDS_BYTES - LDSCTL_OFF) / 4; u += NWAVES * 64) ((LAS unsigned*)(F.lds + LDSCTL_OFF))[u] = 0u;
    __syncthreads();
    { const int t = fresh_tid(); if (t < 32) *(LAS unsigned long long*)(F.lds + INTAB_OFF + 8 * t) = (unsigned long long)args.in[t]; }
    __syncthreads();
#if MK_SINGLE
    XcdBarrier bar = xcd_barrier_post((unsigned*)(F.ctl + CW_BAR), F.MISC + 8);
#define GRID_BAR() xcd_barrier(bar)
#else
#define GRID_BAR() do { } while (0)
#endif
    const int lo = args.ph_lo, hi = args.ph_hi;
#ifndef PHMASK
#define PHMASK 0xFFFF
#endif
#define IN(k) (((PHMASK >> (k)) & 1) && lo <= (k) && (k) < hi)
#ifndef DBLMASK
#define DBLMASK 0
#endif
#define REP(k) _Pragma("unroll 1") for (int rep_ = 0; rep_ <= ((DBLMASK >> (k)) & 1); ++rep_)
#define SEAM(k) do { if (IN(k) && IN((k) + 1)) GRID_BAR(); } while (0)
    LAS unsigned char* ring = F.lds + RING_OFF;
    const int bx = (int)blockIdx.x;

    if (IN(0)) REP(0) { p0_prologue(F); } SEAM(0);
#ifdef XBAR
    for (int xb_ = 0; xb_ < XBAR; ++xb_) GRID_BAR();
#endif

    if (IN(1)) REP(1) {
#ifdef PROBE_BAR
        if (rep_ > 0) GRID_BAR();
#endif
        pg8::Gemm g{WSP(bf16, WS_XB), WSP(bf16, WS_WIN), T, NIN, DM}; pg8::StaticOrder S; S.init(T, NIN, F.G, bx);
        EpiZ E{WSP(float, WS_RSTD1), WSP(float, WS_ROPE), WSP(bf16, WS_QB), WSP(bf16, WS_KB), WSP(bf16, WS_VB), WSP(bf16, WS_ZS), (bf16*)F.out};
        pg8::gemm_phase<EpiZ, pg8::StaticOrder, PG_ALIGN, PG_SP2>(ring, g, S, E, F.wave);
    } SEAM(1);

    if (IN(2)) REP(2) { for (int pm = F.vcu; pm < T / 256; pm += F.G) rp1_phase(F, pm); } SEAM(2);

    if (IN(3)) {
        { pg8::Gemm g{WSP(bf16, WS_LIN), WSP(bf16, WS_WL), T, 1536, 256}; pg8::StaticOrder S; S.init(T, 1536, F.G, bx);
          EpiLora E{INF(6), INF(8), INF(12), WSP(bf16, WS_DEC), WSP(bf16, WS_KR), WSP(bf16, WS_KK), WSP(bf16, WS_BB), WSP(bf16, WS_GG)};
          pg8::gemm_phase<EpiLora, pg8::StaticOrder, PG_ALIGN, PG_SP2>(ring, g, S, E, F.wave); }
        __syncthreads();
        REP(3) attn_phase(F);
    } SEAM(3);

    #ifndef SCAN_MODE
#define SCAN_MODE 0
#endif
    if (IN(4)) REP(4) {
#ifdef SCAN_PROBE_SKIP
        scan_phase_t<false, SCAN_PROBE_SKIP>(F); __syncthreads();
#endif
#if SCAN_MODE != 2
        scan_phase(F);
#endif
#if SCAN_MODE == 3
        __syncthreads(); scan_phase_t<true>(F);
#endif
#if SCAN_MODE == 1 || SCAN_MODE == 2
        __syncthreads(); scan_phase_seq(F);
#endif
    } SEAM(4);

    if (IN(5)) REP(5) {
        pg8::Gemm g{WSP(bf16, WS_Y2), WSP(bf16, WS_WBA), T, DM, DM}; pg8::StaticOrder S; S.init(T, DM, F.G, bx);
        EpiMerge2 E{(const unsigned char*)F.out, WSP(bf16, WS_MRG)}; pg8::gemm_phase<EpiMerge2, pg8::StaticOrder, PG_ALIGN, PG_SP2>(ring, g, S, E, F.wave);
    } SEAM(5);

    if (IN(6)) REP(6) {
        pg8::Gemm g{WSP(bf16, WS_MRG), WSP(bf16, WS_WOUT), T, DM, DM}; pg8::StaticOrder S; S.init(T, DM, F.G, bx);
#ifdef PROBE_EPI6
        if (rep_ == 0) { EpiProbe EP{WSP(float, WS_LOG)}; pg8::gemm_phase<EpiProbe, pg8::StaticOrder, PG_ALIGN, PG_SP2>(ring, g, S, EP, F.wave); __syncthreads(); continue; }
#endif
        EpiOut E{WSP(bf16, WS_XB), WSP(float, WS_SSQ2)};
        pg8::gemm_phase<EpiOut, pg8::StaticOrder, PG_ALIGN, PG_SP2>(ring, g, S, E, F.wave);
    } SEAM(6);

    if (IN(7)) REP(7) {
        pg8::Gemm g{WSP(bf16, WS_XB), WSP(bf16, WS_WR), T, 256, DM}; pg8::StaticOrder S; S.init(T, 256, F.G, bx);
        EpiRouter E{WSP(float, WS_SSQ2), INF(22), INF(24), WSP(float, WS_RSTD2), WSP(float, WS_LOG)};
        pg8::gemm_phase<EpiRouter, pg8::StaticOrder, PG_ALIGN, PG_SP2>(ring, g, S, E, F.wave);
        __syncthreads();
        pg8::Unit u; for (int i = 0; S.next(i, u); ++i) route_tile(F, u.pm);
        for (int i = F.vcu * (NWAVES * 64) + fresh_tid(); i < PMAX; i += F.G * NWAVES * 64) WSP(int, WS_ROWTOK)[i] = 0;
    } SEAM(7);

    if (IN(8)) REP(8) { gather_phase(F); } SEAM(8);

    if (IN(9)) REP(9) {
        const int nrt = WSP(int, WS_META)[0]; LAS int* te = (LAS int*)(F.lds + TILEE_OFF);
        for (int i = fresh_tid(); i < nrt; i += NWAVES * 64) te[i] = WSP(int, WS_META)[64 + i];
        __syncthreads();
        pg8::Gemm g{WSP(bf16, WS_XB), WSP(bf16, WS_WGU), 0, 0, DM}; MoeOrderT<true> S{WSP(int, WS_ROWTOK), nrt * 4, F.G, F.vcu, te};
        EpiGU E{WSP(float, WS_ROWSCALE), WSP(bf16, WS_HID)};
        pg8::gemm_phase<EpiGU, MoeOrderT<true>, PG_ALIGN, PG_SP2>(ring, g, S, E, F.wave);
    } SEAM(9);

    if (IN(10)) REP(10) {
        const int nrt = WSP(int, WS_META)[0]; LAS int* te = (LAS int*)(F.lds + TILEE_OFF);
        for (int i = fresh_tid(); i < nrt; i += NWAVES * 64) te[i] = WSP(int, WS_META)[64 + i];
        __syncthreads();
        pg8::Gemm g{WSP(bf16, WS_HID), WSP(bf16, WS_WD), 0, 0, DEXP}; MoeOrderT<false> S{nullptr, nrt * 4, F.G, F.vcu, te};
        EpiStore E{WSP(bf16, WS_Y), DM};
        pg8::gemm_phase<EpiStore, MoeOrderT<false>, PG_ALIGN, PG_SP2>(ring, g, S, E, F.wave);
    } SEAM(10);

    if (IN(11)) { for (int pm = F.vcu; pm < T / 256; pm += F.G) combine_phase(F, pm); } SEAM(11);

    if (IN(12)) REP(12) {
        { pg8::Gemm g{WSP(bf16, WS_PB), WSP(bf16, WS_WPP), T, DM, PLE}; pg8::StaticOrder S; S.init(T, DM, F.G, bx);
          EpiStoreBlk E{WSP(bf16, WS_PP)}; pg8::gemm_phase<EpiStoreBlk, pg8::StaticOrder, PG_ALIGN, PG_SP2>(ring, g, S, E, F.wave); }
        { pg8::Gemm g{WSP(bf16, WS_XB), WSP(bf16, WS_WPG), T, DM, DM}; pg8::StaticOrder S; S.init(T, DM, F.G, bx);
          EpiPle E{WSP(float, WS_RSTD3), WSP(bf16, WS_XB), WSP(bf16, WS_PP), WSP(bf16, WS_X3B), WSP(float, WS_SSQ4)};
          pg8::gemm_phase<EpiPle, pg8::StaticOrder, PG_ALIGN, PG_SP2>(ring, g, S, E, F.wave); }
    } SEAM(12);

    if (IN(13)) { for (int pm = F.vcu; pm < T / 256; pm += F.G) final_phase(F, pm); }
#undef IN
#undef SEAM
}

extern "C" void kernel_launch(void* const* d_in, const int* in_sizes, int n_in, void* d_out, int out_size, void* d_ws, size_t ws_size, hipStream_t stream) {
    static int grid = 0;
    if (grid == 0) {
        if (n_in != 32 || in_sizes[0] != T * DM || out_size != T * DM || ws_size < WS_END) {
            fprintf(stderr, "kernel_launch: unexpected shapes (n_in %d, in0 %d, out %d, ws %zu); nothing launched\n", n_in, n_in > 0 ? in_sizes[0] : -1, out_size, ws_size); grid = -1; return; }
        int dev = 0, cus = 0, per_cu = 0;
        if (hipGetDevice(&dev) != hipSuccess || hipDeviceGetAttribute(&cus, hipDeviceAttributeMultiprocessorCount, dev) != hipSuccess) { grid = -1; return; }
        if (hipFuncSetAttribute((const void*)fwd_kernel, hipFuncAttributeMaxDynamicSharedMemorySize, LDS_BYTES) != hipSuccess) { fprintf(stderr, "kernel_launch: hipFuncSetAttribute failed\n"); grid = -1; return; }
        if (hipOccupancyMaxActiveBlocksPerMultiprocessor(&per_cu, (const void*)fwd_kernel, NWAVES * 64, LDS_BYTES) != hipSuccess || per_cu < 1) { fprintf(stderr, "kernel_launch: occupancy query says %d blocks per CU\n", per_cu); per_cu = 1; }
        (void)hipGetLastError();
        grid = cus;
    }
    if (grid < 0) return;
    Args a{};
    for (int i = 0; i < 32; ++i) a.in[i] = d_in[i];
    a.out = (float*)d_out; a.ws = (unsigned char*)d_ws;
#if MK_SINGLE
    (void)hipMemsetAsync((char*)d_ws + WS_CTL, 0, CTL_ZERO_BYTES, stream);
    a.ph_lo = 0; a.ph_hi = NPH;
    void* kargs[] = {&a};
    hipError_t e = hipLaunchCooperativeKernel((const void*)fwd_kernel, dim3(grid), dim3(NWAVES * 64), kargs, LDS_BYTES, stream);
    if (e != hipSuccess) fprintf(stderr, "kernel_launch: cooperative launch failed: %s (grid %d)\n", hipGetErrorString(e), grid);
#else
    for (int ph = 0; ph < NPH; ++ph) {
        a.ph_lo = ph; a.ph_hi = ph + 1;
        hipLaunchKernelGGL(fwd_kernel, dim3(grid), dim3(NWAVES * 64), LDS_BYTES, stream, a);
    }
#endif
}
```

```cpp
#include <hip/hip_runtime.h>
#include <hip/hip_bf16.h>
#include <cstdio>
#include <cstdint>
#include <cmath>

#ifndef MK_SINGLE
#define MK_SINGLE 1
#endif

namespace pg8 {
#define PG8_LAS __attribute__((address_space(3)))
typedef unsigned short bf16_t;
typedef short bf16x8 __attribute__((ext_vector_type(8)));
typedef float f32x4 __attribute__((ext_vector_type(4)));
typedef unsigned u32x4 __attribute__((ext_vector_type(4)));
constexpr int BM = 256, BK = 64, HALF = 128, HTB = HALF * BK * 2  , STAGE_BYTES = 8 * HTB, NXCD = 8, WGM = 8;

__host__ __device__ __forceinline__ int lds_byte(int r, int c) { const int st = (r >> 4) * 2 + (c >> 5), rr = r & 15, cc = c & 31, ob = rr * 64 + cc * 2; return st * 1024 + (ob ^ (((ob >> 9) & 1) << 5)); }
__host__ __device__ __forceinline__ void stage_rc(int b, int& R, int& C) { const int st = b / 1024, sb = b % 1024, swz = sb ^ (((sb >> 9) & 1) << 5); R = (st >> 1) * 16 + swz / 64; C = (st & 1) * 32 + (swz % 64) / 2; }
__host__ __device__ __forceinline__ int perm32(int rho) { const int n = rho >> 4, i = rho & 15; return 8 * (i >> 2) + 4 * n + (i & 3); }

struct Unit { int pm, pn, pb; };
struct Gemm { const bf16_t* A; const bf16_t* Bt; int M, N, K; int ldk = 0; };

struct StaticOrder {
    static constexpr bool GATHER = false; __device__ __forceinline__ const int* rowtok() const { return nullptr; }
    int nM, nN, nwg, G, c;
    __host__ __device__ __forceinline__ void init(int M, int N, int G_, int c_) { nM = M / BM; nN = N / BM; nwg = nM * nN; G = G_; c = c_; }
    __host__ __device__ __forceinline__ bool next(int i, Unit& u) const {
        const long L = (long)i * G + c; if (L >= nwg) return false;
        int wgid = (int)L; { const int q = nwg / NXCD, r = nwg % NXCD, xcd = wgid % NXCD, off = wgid / NXCD; wgid = (xcd < r ? xcd * (q + 1) : r * (q + 1) + (xcd - r) * q) + off; }
        const int nig = WGM * nN, gid = wgid / nig, fm = gid * WGM, gsz = (nM - fm) < WGM ? (nM - fm) : WGM;
        u.pm = fm + ((wgid % nig) % gsz); u.pn = (wgid % nig) / gsz; u.pb = u.pn; return true;
    }
    __device__ __forceinline__ void a_ready(const Unit&) const {}
    __device__ __forceinline__ void done(const Unit&) const {}
};

template <class Epi, class Sched, bool ALIGN_EPI = false, bool SP2 = false>
__device__ __forceinline__ void gemm_phase(PG8_LAS unsigned char* lds, const Gemm g, const Sched& S, const Epi& E, const int wave_id) {
    int tid_; asm volatile("v_mbcnt_lo_u32_b32 %0, -1, 0\n\tv_mbcnt_hi_u32_b32 %0, -1, %0" : "=v"(tid_)); tid_ += wave_id * 64;
    const int tid = tid_, wid = __builtin_amdgcn_readfirstlane(tid >> 6), lane = tid & 63, wr = wid >> 2, wc = wid & 3, fr = lane & 15, fq = lane >> 4;
    const int K = g.K, nt = K / BK, LD = g.ldk ? g.ldk : K;
    unsigned voffA[2], voffB[2];
#pragma unroll
    for (int i = 0; i < 2; ++i) { int R, C; stage_rc(tid * 16 + i * 8192, R, C); const int Rb = Epi::PERM ? ((R & ~31) + perm32(R & 31)) : R;
        voffA[i] = (unsigned)(R * LD + C) * 2u; voffB[i] = (unsigned)(Rb * LD + C) * 2u; }
    const size_t kstep = (size_t)(BK * 2);
    const size_t hstep = (size_t)HALF * LD * 2;
    const size_t tstep = 2 * hstep;
    const unsigned ldsw = (unsigned)wid * 1024u;
    const int aoff = lds_byte(wr * 64 + fr, fq * 8), boff = lds_byte(wc * 32 + fr, fq * 8);
#define PG8_SA(b, h) (((b) * 2 + (h)) * HTB)
#define PG8_SB(b, h) ((4 + (b) * 2 + (h)) * HTB)
#define PG8_STAGE(bufoff, gbase, voff) do { _Pragma("unroll") for (int _i = 0; _i < 2; ++_i) \
        __builtin_amdgcn_global_load_lds((const unsigned*)((const char*)(gbase) + (voff)[_i]), (PG8_LAS unsigned*)(lds + (bufoff) + ldsw + _i * 8192), 16, 0, 0); } while (0)
#define PG8_STAGE_A(bufoff, gptr, h, VG) do { if constexpr (Sched::GATHER) { PG8_STAGE(bufoff, gptr, VG[h]); } else { PG8_STAGE(bufoff, (gptr) + (h) * hstep, voffA); } } while (0)
#define PG8_LDA(dst, b, h) do { _Pragma("unroll") for (int m = 0; m < 4; ++m) _Pragma("unroll") for (int k = 0; k < 2; ++k) dst[m][k] = *(const PG8_LAS bf16x8*)(lds + PG8_SA(b, h) + aoff + m * 2048 + k * 1024); } while (0)
#define PG8_LDB(dst, b, h) do { _Pragma("unroll") for (int n = 0; n < 2; ++n) _Pragma("unroll") for (int k = 0; k < 2; ++k) dst[n][k] = *(const PG8_LAS bf16x8*)(lds + PG8_SB(b, h) + boff + n * 2048 + k * 1024); } while (0)
#define PG8_MMA(ai, bj, At, Bt) do { __builtin_amdgcn_s_setprio(1); _Pragma("unroll") for (int m = 0; m < 4; ++m) _Pragma("unroll") for (int n = 0; n < 2; ++n) _Pragma("unroll") for (int k = 0; k < 2; ++k) \
        acc[ai][bj][m][n] = __builtin_amdgcn_mfma_f32_16x16x32_bf16(Bt[n][k], At[m][k], acc[ai][bj][m][n], 0, 0, 0); __builtin_amdgcn_s_setprio(0); } while (0)
#define PG8_WAIT_V(n) asm volatile("s_waitcnt vmcnt(" #n ")" ::: "memory")
#define PG8_WAIT_L(n) asm volatile("s_waitcnt lgkmcnt(" #n ")" ::: "memory")
#define PG8_BAR __builtin_amdgcn_s_barrier()
#define PG8_SCHED __builtin_amdgcn_sched_barrier(0)
    Unit cur, nxt; int ui = 0;
    if (!S.next(0, cur)) return;
    f32x4 acc[2][2][4][2];
#pragma unroll
    for (int a = 0; a < 2; ++a)
#pragma unroll
        for (int b = 0; b < 2; ++b)
#pragma unroll
            for (int m = 0; m < 4; ++m)
#pragma unroll
                for (int n = 0; n < 2; ++n) acc[a][b][m][n] = (f32x4){0.f, 0.f, 0.f, 0.f};
    bf16x8 At[4][2], B0[2][2], B1[2][2];
    unsigned vc[2][2], vn[2][2]; int RA[2], CA[2];
#pragma unroll
    for (int i = 0; i < 2; ++i) { stage_rc(tid * 16 + i * 8192, RA[i], CA[i]); }
    PG8_LAS int* tokl = (PG8_LAS int*)(lds + STAGE_BYTES + 4096);
    if constexpr (Sched::GATHER) {
#pragma unroll
        for (int h = 0; h < 2; ++h)
#pragma unroll
            for (int i = 0; i < 2; ++i) vc[h][i] = (unsigned)S.rowtok()[cur.pm * BM + h * HALF + RA[i]] * (unsigned)(LD * 2) + (unsigned)(CA[i] * 2);
    } else {
#pragma unroll
        for (int h = 0; h < 2; ++h)
#pragma unroll
            for (int i = 0; i < 2; ++i) vc[h][i] = 0u;
    }
#pragma unroll
    for (int h = 0; h < 2; ++h)
#pragma unroll
        for (int i = 0; i < 2; ++i) vn[h][i] = vc[h][i];
    const char* cA = Sched::GATHER ? (const char*)g.A : (const char*)g.A + (size_t)cur.pm * tstep; const char* cB = (const char*)g.Bt + (size_t)cur.pb * tstep;
    S.a_ready(cur);
    if constexpr (SP2) {
        PG8_STAGE(PG8_SB(0, 0), cB, voffB); PG8_STAGE(PG8_SB(0, 1), cB + hstep, voffB); PG8_STAGE_A(PG8_SA(0, 0), cA, 0, vc); PG8_STAGE_A(PG8_SA(0, 1), cA, 1, vc);
        if (wr == 1) PG8_BAR;
        PG8_WAIT_V(2); PG8_BAR;
        PG8_STAGE(PG8_SB(1, 0), cB + kstep, voffB); PG8_STAGE_A(PG8_SA(1, 0), cA + kstep, 0, vc); PG8_STAGE(PG8_SB(1, 1), cB + hstep + kstep, voffB);
        PG8_WAIT_V(6); PG8_BAR;
    } else {
        PG8_STAGE(PG8_SB(0, 0), cB, voffB); PG8_STAGE_A(PG8_SA(0, 0), cA, 0, vc); PG8_STAGE(PG8_SB(0, 1), cB + hstep, voffB); PG8_STAGE_A(PG8_SA(0, 1), cA, 1, vc);
        if (wr == 1) PG8_BAR;
        PG8_WAIT_V(4); PG8_BAR;
        PG8_STAGE(PG8_SB(1, 0), cB + kstep, voffB); PG8_STAGE_A(PG8_SA(1, 0), cA + kstep, 0, vc); PG8_STAGE(PG8_SB(1, 1), cB + hstep + kstep, voffB);
        PG8_WAIT_V(6); PG8_BAR;
    }
    for (;;) {
        const bool has_next = S.next(ui + 1, nxt);
        const char* nA = Sched::GATHER ? cA : (has_next ? (const char*)g.A + (size_t)nxt.pm * tstep : cA); const char* nB = has_next ? (const char*)g.Bt + (size_t)nxt.pb * tstep : cB;
        if constexpr (Sched::GATHER) { if (has_next && wid == 0) __builtin_amdgcn_global_load_lds((const unsigned*)(S.rowtok() + nxt.pm * BM + lane * 4), (PG8_LAS unsigned*)(tokl + ((ui + 1) & 1) * 256), 16, 0, 0); }
        for (int t = 0; t < nt; t += 2) {
            if constexpr (Epi::MIDK_T > 0) { if (t == Epi::MIDK_T) E.mid(acc, cur, wr, wc, fr, fq); }
            const bool last = (t == nt - 2);
            if constexpr (Sched::GATHER) { if (last && has_next) {
#pragma unroll
                for (int h = 0; h < 2; ++h)
#pragma unroll
                    for (int i = 0; i < 2; ++i) vn[h][i] = (unsigned)tokl[((ui + 1) & 1) * 256 + h * HALF + RA[i]] * (unsigned)(LD * 2) + (unsigned)(CA[i] * 2); } }
            unsigned v2[2][2];
#pragma unroll
            for (int h = 0; h < 2; ++h)
#pragma unroll
                for (int i = 0; i < 2; ++i) v2[h][i] = (Sched::GATHER && last) ? vn[h][i] : vc[h][i];
            const char* a1 = cA + (size_t)(t + 1) * kstep;
            const char* a2 = last ? nA : cA + (size_t)(t + 2) * kstep; const char* b2 = last ? nB : cB + (size_t)(t + 2) * kstep;
            const char* a3 = a2 + kstep; const char* b3 = b2 + kstep;
            if (last && has_next) S.a_ready(nxt);
            if constexpr (SP2) {
            PG8_LDB(B0, 0, 0); PG8_LDB(B1, 0, 1); PG8_SCHED; PG8_LDA(At, 0, 0); PG8_STAGE_A(PG8_SA(1, 1), a1, 1, vc);
            PG8_WAIT_V(8); PG8_WAIT_L(0); PG8_BAR; PG8_MMA(0, 0, At, B0); PG8_MMA(0, 1, At, B1); PG8_BAR; PG8_SCHED;
            PG8_LDA(At, 0, 1); PG8_STAGE(PG8_SB(0, 0), b2, voffB); PG8_STAGE(PG8_SB(0, 1), b2 + hstep, voffB); PG8_STAGE_A(PG8_SA(0, 0), a2, 0, v2);
            PG8_WAIT_V(8); PG8_WAIT_L(0); PG8_BAR; PG8_MMA(1, 0, At, B0); PG8_MMA(1, 1, At, B1); PG8_BAR; PG8_SCHED;
            PG8_LDB(B0, 1, 0); PG8_LDB(B1, 1, 1); PG8_SCHED; PG8_LDA(At, 1, 0); PG8_STAGE_A(PG8_SA(0, 1), a2, 1, v2);
            PG8_WAIT_V(8); PG8_WAIT_L(0); PG8_BAR; PG8_MMA(0, 0, At, B0); PG8_MMA(0, 1, At, B1); PG8_BAR; PG8_SCHED;
            PG8_LDA(At, 1, 1); PG8_STAGE(PG8_SB(1, 0), b3, voffB); PG8_STAGE(PG8_SB(1, 1), b3 + hstep, voffB); PG8_STAGE_A(PG8_SA(1, 0), a3, 0, v2);
            PG8_WAIT_V(8); PG8_WAIT_L(0); PG8_BAR; PG8_MMA(1, 0, At, B0); PG8_MMA(1, 1, At, B1); PG8_BAR; PG8_SCHED;
            } else {
            PG8_LDB(B0, 0, 0); PG8_SCHED; PG8_LDA(At, 0, 0); PG8_STAGE_A(PG8_SA(1, 1), a1, 1, vc);
            PG8_WAIT_L(8); PG8_BAR; PG8_WAIT_L(0); PG8_MMA(0, 0, At, B0); PG8_BAR; PG8_SCHED;
            PG8_LDB(B1, 0, 1); PG8_STAGE(PG8_SB(0, 0), b2, voffB);
            PG8_BAR; PG8_WAIT_L(0); PG8_MMA(0, 1, At, B1); PG8_BAR;
            PG8_LDA(At, 0, 1); PG8_STAGE_A(PG8_SA(0, 0), a2, 0, v2);
            PG8_BAR; PG8_WAIT_L(0); PG8_MMA(1, 0, At, B0); PG8_BAR; PG8_SCHED;
            PG8_STAGE(PG8_SB(0, 1), b2 + hstep, voffB);
            PG8_WAIT_V(6); PG8_BAR; PG8_MMA(1, 1, At, B1); PG8_BAR;
            PG8_LDB(B0, 1, 0); PG8_SCHED; PG8_LDA(At, 1, 0); PG8_STAGE_A(PG8_SA(0, 1), a2, 1, v2);
            PG8_WAIT_L(8); PG8_BAR; PG8_WAIT_L(0); PG8_MMA(0, 0, At, B0); PG8_BAR; PG8_SCHED;
            PG8_LDB(B1, 1, 1); PG8_STAGE(PG8_SB(1, 0), b3, voffB);
            PG8_BAR; PG8_WAIT_L(0); PG8_MMA(0, 1, At, B1); PG8_BAR;
            PG8_LDA(At, 1, 1); PG8_STAGE_A(PG8_SA(1, 0), a3, 0, v2);
            PG8_BAR; PG8_WAIT_L(0); PG8_MMA(1, 0, At, B0); PG8_BAR; PG8_SCHED;
            PG8_STAGE(PG8_SB(1, 1), b3 + hstep, voffB);
            PG8_WAIT_V(6); PG8_BAR; PG8_MMA(1, 1, At, B1); PG8_BAR;
            }
        }
        if constexpr (ALIGN_EPI) { if (wr == 0) PG8_BAR; }
        if constexpr (!Epi::AFTER_DRAIN) { E(acc, cur, wr, wc, fr, fq); S.done(cur); }
        if (!has_next) break;
#pragma unroll
        for (int a = 0; a < 2; ++a)
#pragma unroll
            for (int b = 0; b < 2; ++b)
#pragma unroll
                for (int m = 0; m < 4; ++m)
#pragma unroll
                    for (int n = 0; n < 2; ++n) acc[a][b][m][n] = (f32x4){0.f, 0.f, 0.f, 0.f};
        cur = nxt; cA = nA; cB = nB; ++ui;
        if constexpr (Sched::GATHER) {
#pragma unroll
            for (int h = 0; h < 2; ++h)
#pragma unroll
                for (int i = 0; i < 2; ++i) vc[h][i] = vn[h][i]; }
        if constexpr (ALIGN_EPI) { if (wr == 1) PG8_BAR; }
    }
    PG8_WAIT_V(0);
    if constexpr (!ALIGN_EPI) { if (wr == 0) PG8_BAR; }
    PG8_BAR;
    if constexpr (Epi::AFTER_DRAIN) { E.fused(acc, cur, wr, wc, fr, fq, lds, wid, lane); S.done(cur); }
#undef PG8_SA
#undef PG8_SB
#undef PG8_STAGE
#undef PG8_STAGE_A
#undef PG8_LDA
#undef PG8_LDB
#undef PG8_MMA
#undef PG8_WAIT_V
#undef PG8_WAIT_L
#undef PG8_BAR
#undef PG8_SCHED
}
}
#define GAS __attribute__((address_space(1)))
#define LAS __attribute__((address_space(3)))
typedef unsigned short bf16;
typedef unsigned v4u __attribute__((ext_vector_type(4)));
typedef float f32x4 __attribute__((ext_vector_type(4)));
typedef short bf16x8 __attribute__((ext_vector_type(8)));
typedef GAS unsigned gu32;
typedef GAS unsigned long long gu64;
#define RLX_AGENT __ATOMIC_RELAXED, __HIP_MEMORY_SCOPE_AGENT
#define LDS_WAIT() asm volatile("s_waitcnt lgkmcnt(0)" ::: "memory")
#define VM_WAIT() asm volatile("s_waitcnt vmcnt(0)" ::: "memory")
__device__ __forceinline__ unsigned long long rt() { return __builtin_amdgcn_s_memrealtime(); }
__device__ __forceinline__ unsigned f2bf(float f) { unsigned u = __builtin_bit_cast(unsigned, f); return (u + 0x7fffu + ((u >> 16) & 1u)) >> 16; }
__device__ __forceinline__ unsigned pk2(float lo, float hi) { return f2bf(lo) | (f2bf(hi) << 16); }

#define XB_TMO      128
#define XB_XCNT(j)  (256  + 64 * (j))
#define XB_XSUB(j)  (1280 + 64 * (j))
#define XB_XGEN(j)  (2304 + 64 * (j))
#define XB_TOP      3328
#define XB_TOPGEN   3392
#define XCD_BAR_WORDS 3456
#define XB_SPIN_CAP (1u << 18)

__device__ __forceinline__ unsigned xb_ld(unsigned* p)              { return __hip_atomic_load(p, __ATOMIC_RELAXED, __HIP_MEMORY_SCOPE_AGENT); }
__device__ __forceinline__ unsigned xb_add(unsigned* p, unsigned v) { return __hip_atomic_fetch_add(p, v, __ATOMIC_RELAXED, __HIP_MEMORY_SCOPE_AGENT); }
__device__ __forceinline__ unsigned xb_xcc_id() { return (unsigned)__builtin_amdgcn_s_getreg((3 << 11) | 20) & 0xFu; }
#define XB_SPIN(cond, bar) do { unsigned _sp = 0; while (cond) { __builtin_amdgcn_s_sleep(1); \
    if ((++_sp & 255u) == 0u) { if (xb_ld(&(bar)[XB_TMO])) break; if (_sp > XB_SPIN_CAP) { atomicAdd(&(bar)[XB_TMO], 1u); break; } } } } while (0)

struct XcdBarrier {
    unsigned* bar; unsigned x;
    volatile LAS unsigned* st;
};

__device__ __forceinline__ XcdBarrier xcd_barrier_post(unsigned* bar, volatile LAS unsigned* st) {
    XcdBarrier b; b.bar = bar; b.x = xb_xcc_id(); b.st = st;
    if (threadIdx.x == 0) (void)xb_add(&bar[XB_XCNT(b.x)], 1u);
    return b;
}
__device__ __forceinline__ void xcd_barrier_complete(unsigned* bar, unsigned x, unsigned& nloc, unsigned& nx) {
    const unsigned G = gridDim.x * gridDim.y * gridDim.z;
    unsigned sum, cnt, mine, sp = 0u;
    for (;;) {
        sum = 0u; cnt = 0u; mine = 0u;
#pragma unroll
        for (unsigned j = 0; j < 16; ++j) { const unsigned c = xb_ld(&bar[XB_XCNT(j)]); sum += c; cnt += (c > 0u) ? 1u : 0u; mine = (j == x) ? c : mine; }
        if (sum == G) break;
        __builtin_amdgcn_s_sleep(1);
        if ((++sp & 255u) == 0u) { if (xb_ld(&bar[XB_TMO])) break; if (sp > XB_SPIN_CAP) { atomicAdd(&bar[XB_TMO], 1u); break; } }
    }
    nloc = mine > 0u ? mine : 1u; nx = cnt > 0u ? cnt : 1u;
}

__device__ __forceinline__ void xcd_barrier(const XcdBarrier& b) {
    asm volatile("s_waitcnt vmcnt(0)" ::: "memory");
    __syncthreads();
    if (threadIdx.x == 0) {
        unsigned* bar = b.bar;
        __builtin_amdgcn_s_waitcnt(0);
        unsigned nloc = b.st[0], nx = b.st[1];
        if (nloc == 0u) { xcd_barrier_complete(bar, b.x, nloc, nx); b.st[0] = nloc; b.st[1] = nx; }
        const unsigned old = xb_add(&bar[XB_XSUB(b.x)], 1u);
        const unsigned gen = old / nloc;
        if (old + 1u == (gen + 1u) * nloc) {
            __builtin_amdgcn_fence(__ATOMIC_RELEASE, "agent");
            asm volatile("s_waitcnt vmcnt(0)" ::: "memory");
            const unsigned og = xb_add(&bar[XB_TOP], 1u);
            const unsigned tg = og / nx;
            if (og + 1u == (tg + 1u) * nx) xb_add(&bar[XB_TOPGEN], 1u);
            else XB_SPIN(xb_ld(&bar[XB_TOPGEN]) == tg, bar);
            __builtin_amdgcn_fence(__ATOMIC_ACQUIRE, "agent");
            xb_add(&bar[XB_XGEN(b.x)], 1u);
            asm volatile("s_waitcnt vmcnt(0)" ::: "memory");
        } else {
            XB_SPIN(xb_ld(&bar[XB_XGEN(b.x)]) == gen, bar);
            __builtin_amdgcn_fence(__ATOMIC_ACQUIRE, "agent");
            asm volatile("s_waitcnt vmcnt(0)" ::: "memory");
        }
    }
    __syncthreads();
}

constexpr int NWAVES = 8;
constexpr int BATCH = 32, SEQ = 2048, DM = 1024, T = BATCH * SEQ;
constexpr int PLE = 256, NIN = 4608, NSHIFT = 1792, CW = 512;
constexpr int NEXP = 32, DEXP = 512;
constexpr int PMAX = 2 * T + NEXP * 256;
constexpr int NRT_MAX = PMAX / 256;
constexpr float NORM_EPS = 1e-6f, GN_EPS = 64e-5f;
constexpr float LOG2E = 1.4426950408889634f;
constexpr float QSCALE = 0.125f * LOG2E;

constexpr size_t MiB = 1u << 20;
constexpr size_t WS_CTL = 0, CTL_ZERO_BYTES = 65536;
constexpr size_t WS_RSTD1 = 1 * MiB, WS_RSTD2 = 1 * MiB + 256 * 1024, WS_RSTD3 = 1 * MiB + 512 * 1024;
constexpr size_t WS_WIN = 2 * MiB, WS_WBA = 11 * MiB, WS_WBB = 12 * MiB, WS_WOUT = 13 * MiB, WS_WR = 15 * MiB, WS_WL = 15 * MiB + 512 * 1024;
constexpr size_t WS_WPP = 16 * MiB + 512 * 1024, WS_WPG = 17 * MiB, WS_WGU = 19 * MiB, WS_WD = 83 * MiB;
constexpr size_t WS_SSQ2 = 115 * MiB, WS_SSQ4 = 119 * MiB;
constexpr size_t WS_ROWTOK = 119 * MiB;
constexpr size_t WS_RT_E = 123 * MiB, WS_RT_W = 123 * MiB + 512 * 1024, WS_RT_RANK = 124 * MiB, WS_RT_POS = 124 * MiB + 512 * 1024;
constexpr size_t WS_ROWSCALE = 125 * MiB;
constexpr size_t WS_TABLE = 126 * MiB;
constexpr size_t WS_META = 126 * MiB + 256 * 1024;
constexpr size_t WS_PB = 128 * MiB, WS_XB = 160 * MiB;
constexpr size_t WS_QB = 288 * MiB, WS_KB = 352 * MiB, WS_VB = 368 * MiB, WS_ZS = 384 * MiB;
constexpr size_t WS_R = 608 * MiB, WS_KR = 672 * MiB, WS_VR = 736 * MiB, WS_KK = 800 * MiB, WS_LIN = 864 * MiB;
constexpr size_t WS_ROPE = 608 * MiB;
constexpr size_t WS_DEC = 608 * MiB, WS_BB = 672 * MiB, WS_GG = 896 * MiB;
constexpr size_t WS_Y2 = 736 * MiB, WS_MRG = 384 * MiB;
constexpr size_t WS_X1 = 608 * MiB;
constexpr size_t WS_LOG = 560 * MiB;
constexpr size_t WS_XS = 288 * MiB, WS_HID = 864 * MiB, WS_Y = 288 * MiB, WS_PP = 864 * MiB;
constexpr size_t WS_X3B = 608 * MiB;
constexpr size_t WS_END = 1024 * MiB;
static_assert(WS_XS + (size_t)PMAX * DM * 2 <= WS_LOG && WS_HID + (size_t)PMAX * DEXP * 2 <= WS_END, "ws map");
constexpr int CW_BAR = 4096;

constexpr int RING_OFF = 0, RING_BYTES = 131072;
constexpr int LDSCTL_OFF = RING_BYTES, MISC_OFF = LDSCTL_OFF + 320;
constexpr int INTAB_OFF = RING_BYTES + 512;
constexpr int TILEE_OFF = RING_BYTES + 1024;
constexpr int LDS_BYTES = 147456;

typedef float f32x2 __attribute__((ext_vector_type(2)));
typedef float f32x16 __attribute__((ext_vector_type(16)));
typedef unsigned u32x2 __attribute__((ext_vector_type(2)));
typedef short s16x4 __attribute__((ext_vector_type(4)));

struct Frame {
    LAS unsigned char* lds;
    volatile LAS unsigned* MISC;
    gu32* ctl;
    int wave;
    int vcu, G;
    unsigned char* ws;
    float* out;
};
__device__ __forceinline__ const void* in_ptr(LAS unsigned char* lds, int i) {
    const LAS unsigned* p = (const LAS unsigned*)(lds + INTAB_OFF) + 2 * i; const unsigned lo = __builtin_amdgcn_readfirstlane(p[0]), hi = __builtin_amdgcn_readfirstlane(p[1]);
    return (const void*)(((unsigned long long)hi << 32) | lo); }
#define INF(i) ((const float*)in_ptr(F.lds, (i)))
#define WSP(type, off) ((type*)(F.ws + (off)))

#define fresh_tid() fresh_tid_(F.wave)
__device__ __forceinline__ int fresh_tid_(int wave) { int l; asm volatile("v_mbcnt_lo_u32_b32 %0, -1, 0\n\tv_mbcnt_hi_u32_b32 %0, -1, %0" : "=v"(l)); return wave * 64 + l; }
__device__ __forceinline__ float wave_sum(float v) {
#pragma unroll
    for (int o = 1; o < 64; o <<= 1) v += __shfl_xor(v, o);
    return v;
}
typedef float f32x2c_t __attribute__((ext_vector_type(2))); typedef __bf16 bf16x2c_t __attribute__((ext_vector_type(2)));
__device__ __forceinline__ unsigned cvt_pk(float lo, float hi) { const f32x2c_t v = {lo, hi}; const bf16x2c_t b = __builtin_convertvector(v, bf16x2c_t); return __builtin_bit_cast(unsigned, b); }
__device__ __forceinline__ float bflo(unsigned w) { return __uint_as_float(w << 16); }
__device__ __forceinline__ float bfhi(unsigned w) { return __uint_as_float(w & 0xffff0000u); }
__device__ __forceinline__ float bf1(unsigned short h) { return __uint_as_float((unsigned)h << 16); }
__device__ __forceinline__ float sigmoidf_(float x) { return __builtin_amdgcn_rcpf(1.0f + __expf(-x)); }
__device__ __forceinline__ u32x2 pack4(f32x4 v) { u32x2 w; w.x = cvt_pk(v[0], v[1]); w.y = cvt_pk(v[2], v[3]); return w; }
__device__ __forceinline__ f32x4 unpack4(u32x2 w) { return (f32x4){bflo(w.x), bfhi(w.x), bflo(w.y), bfhi(w.y)}; }

__device__ __forceinline__ int dest_row(int mode, int rowbase, int n) {
    if (mode == 0) return rowbase + n;
    if (mode == 1) { if (n >= 640) return n; const int d = n & 63, dd = d & 31; return (n & ~63) + 32 * (dd >> 4) + 8 * ((dd >> 2) & 3) + 4 * (d >> 5) + (dd & 3); }
    if (mode == 2) return rowbase + 256 * (n >> 7) + (n & 127);
    return rowbase + 256 * (n >> 7) + 128 + (n & 127);
}
struct TrItem { const float* W; int K, N; bf16* WT; int mode, rowbase; int ks; int item; int ldo, koff; };
__device__ __forceinline__ void tr_load(const TrItem& p, int lane, f32x4 (&v)[8]) {
    const int nkb = p.K / 64, kb = p.item % nkb, nb = p.item / nkb, k0 = 64 * kb, n0 = 32 * nb;
#pragma unroll
    for (int i = 0; i < 8; ++i) { const int kk = 8 * i + (lane >> 3); v[i] = __builtin_nontemporal_load((const GAS f32x4*)(p.W + (size_t)(k0 + kk) * p.N + n0 + 4 * (lane & 7))); }
}
__device__ __forceinline__ void tr_finish(const TrItem& p, int lane, const f32x4 (&v)[8], LAS float* scr, const LAS float* gl) {
    const int nkb = p.K / 64, kb = p.item % nkb, nb = p.item / nkb, k0 = 64 * kb, n0 = 32 * nb;
#pragma unroll
    for (int i = 0; i < 8; ++i) { const int kk = 8 * i + (lane >> 3); const float g = p.ks ? gl[(p.ks - 1) * 1024 + k0 + kk] : 1.0f; LAS float* w = scr + kk * 33 + 4 * (lane & 7);
        w[0] = v[i][0] * g; w[1] = v[i][1] * g; w[2] = v[i][2] * g; w[3] = v[i][3] * g; }
    LDS_WAIT(); asm volatile("" ::: "memory");
    const int c = lane & 7;
#pragma unroll
    for (int j = 0; j < 4; ++j) { const int n = (lane >> 3) + 8 * j; const LAS float* s = scr + (8 * c) * 33 + n;
        v4u o; o.x = pk2(s[0 * 33], s[1 * 33]); o.y = pk2(s[2 * 33], s[3 * 33]); o.z = pk2(s[4 * 33], s[5 * 33]); o.w = pk2(s[6 * 33], s[7 * 33]);
        *(GAS v4u*)(p.WT + (size_t)dest_row(p.mode, p.rowbase, n0 + n) * p.ldo + p.koff + k0 + 8 * c) = o; }
    LDS_WAIT(); asm volatile("" ::: "memory");
}

__device__ __forceinline__ void p0_prologue(Frame& F) {
    LAS float* scr = (LAS float*)(F.lds + RING_OFF + F.wave * 16384);
    const int tid = fresh_tid(), lane = tid & 63;
    const int gw = F.vcu * NWAVES + F.wave, NGW = F.G * NWAVES;
    constexpr int I_WIN = 16 * 144, I_WB = 8 * 32, I_WO = 16 * 32, I_PP = 4 * 32, I_EG = 16 * 16, I_ED = 8 * 32;
    constexpr int NITEMS = I_WIN + 2 * I_WB + 2 * I_WO + I_PP + NEXP * (2 * I_EG + I_ED);
    const float* w_in = INF(4); const float* lnmix = INF(3); const float* wba = INF(17); const float* wbb = INF(18); const float* wout = INF(19); const float* wpg = INF(29); const float* lnple = INF(28);
    const float* wpp = INF(30); const float* wge = INF(25); const float* wue = INF(26); const float* wde = INF(27); const float* lnmoe = INF(20);
    LAS float* gl = (LAS float*)(F.lds + RING_BYTES + 1024);
    for (int i = tid; i < 1024; i += NWAVES * 64) { gl[i] = lnmix[i]; gl[1024 + i] = lnple[i]; gl[2048 + i] = lnmoe[i]; }
    __syncthreads();
    auto decode = [&](int it) -> TrItem { int r = it;
        if (r < I_WIN) return TrItem{w_in, DM, NIN, WSP(bf16, WS_WIN), 1, 0, 1, r, DM, 0}; r -= I_WIN;
        if (r < I_WB) return TrItem{wba, CW, DM, WSP(bf16, WS_WBA), 0, 0, 0, r, DM, 0}; r -= I_WB;
        if (r < I_WB) return TrItem{wbb, CW, DM, WSP(bf16, WS_WBA), 0, 0, 0, r, DM, CW}; r -= I_WB;
        if (r < I_WO) return TrItem{wout, DM, DM, WSP(bf16, WS_WOUT), 0, 0, 0, r, DM, 0}; r -= I_WO;
        if (r < I_WO) return TrItem{wpg, DM, DM, WSP(bf16, WS_WPG), 0, 0, 2, r, DM, 0}; r -= I_WO;
        if (r < I_PP) return TrItem{wpp, PLE, DM, WSP(bf16, WS_WPP), 0, 0, 0, r, PLE, 0}; r -= I_PP;
        if (r < NEXP * I_EG) { const int e = r / I_EG; return TrItem{wge + (size_t)e * DM * DEXP, DM, DEXP, WSP(bf16, WS_WGU), 2, e * 1024, 3, r % I_EG, DM, 0}; } r -= NEXP * I_EG;
        if (r < NEXP * I_EG) { const int e = r / I_EG; return TrItem{wue + (size_t)e * DM * DEXP, DM, DEXP, WSP(bf16, WS_WGU), 3, e * 1024, 3, r % I_EG, DM, 0}; } r -= NEXP * I_EG;
        const int e = r / I_ED; return TrItem{wde + (size_t)e * DEXP * DM, DEXP, DM, WSP(bf16, WS_WD), 0, e * 1024, 0, r % I_ED, DEXP, 0}; };
#ifndef P0DBL
#define P0DBL 0
#endif
#define TR_STEP(X, CX, vY, Z, CZ, vZ) { vZ = itn < iend; if (vZ) { CZ = decode(itn); tr_load(CZ, lane, Z); } itn += 1; tr_finish(CX, lane, X, scr, gl); if (!(vY)) break; }
#define TR_RUN(LO, HI) do { const int n_ = (HI) - (LO), ipw = (n_ + NGW - 1) / NGW, i0 = (LO) + gw * ipw, iend = (i0 + ipw < (HI)) ? i0 + ipw : (HI); \
        if (i0 < iend) { TrItem ca = decode(i0), cb = ca, cc = ca; f32x4 a[8], b[8], c[8]; bool va = true, vb, vc = false; \
            tr_load(ca, lane, a); vb = (i0 + 1) < iend; if (vb) { cb = decode(i0 + 1); tr_load(cb, lane, b); } int itn = i0 + 2; \
            for (;;) { TR_STEP(a, ca, vb, c, cc, vc) TR_STEP(b, cb, vc, a, ca, va) TR_STEP(c, cc, va, b, cb, vb) } } } while (0)
    constexpr int I_DENSE = I_WIN + 2 * I_WB + 2 * I_WO + I_PP;
    TR_RUN(I_DENSE, NITEMS);
    const int gt = F.vcu * (NWAVES * 64) + tid, NGT = F.G * NWAVES * 64;
    const float* wdu = INF(7); const float* wau = INF(9); const float* wgu = INF(10); const float* wgr = INF(21); const float* wex = INF(23); const float* lnm = INF(20);
    const float* pin = INF(1); const float* xin = INF(0); const int* posin = (const int*)INF(2);
    for (int it = gt; it < 1536 * 32; it += NGT) {
        const int row = it >> 5, k8 = (it & 31) * 8; const int blk = row >> 9, n = row & 511;
        float v[8];
#pragma unroll
        for (int j = 0; j < 8; ++j) { const int k = k8 + j; float x = 0.f;
            if (blk == 0 && k < 64) x = wdu[(size_t)k * CW + n];
            else if (blk == 1 && k >= 64 && k < 128) x = wau[(size_t)(k - 64) * CW + n];
            else if (blk == 2 && k >= 128) x = wgu[(size_t)(k - 128) * CW + n];
            v[j] = x; }
        v4u o; o.x = pk2(v[0], v[1]); o.y = pk2(v[2], v[3]); o.z = pk2(v[4], v[5]); o.w = pk2(v[6], v[7]);
        *(GAS v4u*)(WSP(bf16, WS_WL) + (size_t)row * 256 + k8) = o;
    }
    for (int it = gt; it < 256 * 128; it += NGT) {
        const int row = it >> 7, k8 = (it & 127) * 8; float v[8];
#pragma unroll
        for (int j = 0; j < 8; ++j) { const int k = k8 + j; float x = 0.f;
            if (row < 4) x = wgr[(size_t)k * 4 + row] * lnm[k];
            else if (row < 36) x = wex[(size_t)k * NEXP + (row - 4)] * lnm[k];
            v[j] = x; }
        v4u o; o.x = pk2(v[0], v[1]); o.y = pk2(v[2], v[3]); o.z = pk2(v[4], v[5]); o.w = pk2(v[6], v[7]);
        *(GAS v4u*)(WSP(bf16, WS_WR) + (size_t)row * DM + k8) = o;
    }
    _Pragma("unroll 1") for (int rp_ = 0; rp_ <= ((P0DBL >> 1) & 1); ++rp_)
#pragma unroll 8
    for (int it = gt; it < T * PLE / 8; it += NGT) {
        const GAS f32x4* s = (const GAS f32x4*)pin + (size_t)it * 2; const f32x4 a = __builtin_nontemporal_load(s), b = __builtin_nontemporal_load(s + 1);
        v4u o; o.x = pk2(a[0], a[1]); o.y = pk2(a[2], a[3]); o.z = pk2(b[0], b[1]); o.w = pk2(b[2], b[3]);
        *(GAS v4u*)(WSP(bf16, WS_PB) + (size_t)it * 8) = o;
    }
    _Pragma("unroll 1") for (int rp_ = 0; rp_ <= ((P0DBL >> 3) & 1); ++rp_)
    for (int m = 4 * gw; m < T; m += 4 * NGW) {
        f32x4 v[4][4]; float s[4];
#pragma unroll
        for (int q = 0; q < 4; ++q) { const GAS f32x4* xr = (const GAS f32x4*)(xin + (size_t)(m + q) * DM) + lane;
#pragma unroll
            for (int j = 0; j < 4; ++j) v[q][j] = __builtin_nontemporal_load(xr + 64 * j); }
#pragma unroll
        for (int q = 0; q < 4; ++q) { s[q] = 0.f;
#pragma unroll
            for (int j = 0; j < 4; ++j) s[q] += (v[q][j].x * v[q][j].x + v[q][j].y * v[q][j].y) + (v[q][j].z * v[q][j].z + v[q][j].w * v[q][j].w); }
#pragma unroll
        for (int o = 1; o < 64; o <<= 1) {
#pragma unroll
            for (int q = 0; q < 4; ++q) s[q] += __shfl_xor(s[q], o); }
        { float sv = s[0]; if (lane == 1) sv = s[1]; asm volatile("" : "+v"(sv)); if (lane == 2) sv = s[2]; asm volatile("" : "+v"(sv)); if (lane == 3) sv = s[3];
          if (lane < 4) WSP(float, WS_RSTD1)[m + lane] = 1.0f / sqrtf(sv * (1.0f / DM) + NORM_EPS); }
#pragma unroll
        for (int q = 0; q < 4; ++q) {
            GAS unsigned long long* o8 = (GAS unsigned long long*)(WSP(bf16, WS_XB) + (size_t)(m + q) * DM) + lane;
#pragma unroll
            for (int j = 0; j < 4; ++j) o8[64 * j] = (unsigned long long)pk2(v[q][j].x, v[q][j].y) | ((unsigned long long)pk2(v[q][j].z, v[q][j].w) << 32); }
    }
    _Pragma("unroll 1") for (int rp_ = 0; rp_ <= ((P0DBL >> 2) & 1); ++rp_)
#pragma unroll 4
    for (int it = gt; it < T * 32; it += NGT) {
        const int t = it >> 5, i = it & 31; const int pos = posin[t];
        const float inv = exp2f(-(float)i * (13.287712379549449f / 32.0f));
        const float ang = (float)pos * inv;
        const float rev = ang * 0.15915494309189535f; const float fr = rev - floorf(rev);
        const float s = __builtin_amdgcn_sinf(fr), c = __builtin_amdgcn_cosf(fr);
        WSP(float, WS_ROPE)[(size_t)t * 64 + i] = c; WSP(float, WS_ROPE)[(size_t)t * 64 + 32 + i] = s;
    }
    TR_RUN(0, I_DENSE);
#undef TR_RUN
#undef TR_STEP
}

#define EPI_LOOP_ROWS for (int ai = 0; ai < 2; ++ai) _Pragma("unroll") for (int m = 0; m < 4; ++m)
__device__ __forceinline__ v4u pack8(f32x4 a, f32x4 b) { v4u w; w.x = cvt_pk(a[0], a[1]); w.y = cvt_pk(a[2], a[3]); w.z = cvt_pk(b[0], b[1]); w.w = cvt_pk(b[2], b[3]); return w; }
__device__ __forceinline__ f32x4 unlo(v4u w) { return (f32x4){bflo(w.x), bfhi(w.x), bflo(w.y), bfhi(w.y)}; }
__device__ __forceinline__ f32x4 unhi(v4u w) { return (f32x4){bflo(w.z), bfhi(w.z), bflo(w.w), bfhi(w.w)}; }
__device__ __forceinline__ f32x4 sig4(f32x4 v) { f32x4 g; g[0] = sigmoidf_(v[0]); g[1] = sigmoidf_(v[1]); g[2] = sigmoidf_(v[2]); g[3] = sigmoidf_(v[3]); return g; }

__device__ __forceinline__ size_t gate_blk(int pm, int g, int ai, int m, int wr, int wc) { return ((size_t)(((((pm * 8 + g) * 2 + ai) * 4 + m) * 2 + wr) * 4 + wc)) * 1024; }
struct EpiZ {
    static constexpr bool PERM = true, AFTER_DRAIN = false; static constexpr int MIDK_T = 0;
    const float* rstd; const float* rope; bf16 *Qb, *Kb, *Vb, *Zs, *Gt;
    __device__ __forceinline__ void operator()(const f32x4 (&acc)[2][2][4][2], const pg8::Unit& u, int wr, int wc, int fr, int fq) const {
        const int pn = u.pn; const int row0 = u.pm * 256 + wr * 64 + fr;
        float rsv[2][4];
#pragma unroll
        EPI_LOOP_ROWS rsv[ai][m] = rstd[row0 + ai * 128 + m * 16];
        if (pn < 3) {
            const int d0 = 16 * (wc & 1) + 4 * fq;
#pragma unroll
            for (int ai = 0; ai < 2; ++ai) { f32x4 csv[4], snv[4];
#pragma unroll
              for (int m = 0; m < 4; ++m) { const float* rp = rope + (size_t)(row0 + ai * 128 + m * 16) * 64 + d0; csv[m] = *(const f32x4*)rp; snv[m] = *(const f32x4*)(rp + 32); }
#pragma unroll
              for (int m = 0; m < 4; ++m) { const int row = row0 + ai * 128 + m * 16; const float rs = rsv[ai][m];
                const f32x4 cs = csv[m], sn = snv[m];
#pragma unroll
                for (int bj = 0; bj < 2; ++bj) { const f32x4 v0 = acc[ai][bj][m][0] * rs, v1 = acc[ai][bj][m][1] * rs;
                    if (pn < 2) { const int head = pn * 4 + bj * 2 + (wc >> 1); const f32x4 o0 = (v0 * cs - v1 * sn) * QSCALE, o1 = (v1 * cs + v0 * sn) * QSCALE;
                        bf16* p = Qb + (size_t)row * CW + head * 64 + d0; *(u32x2*)p = pack4(o0); *(u32x2*)(p + 32) = pack4(o1); }
                    else if (bj == 0) { const int kvh = wc >> 1; const f32x4 o0 = v0 * cs - v1 * sn, o1 = v1 * cs + v0 * sn;
                        bf16* p = Kb + (size_t)row * 128 + kvh * 64 + d0; *(u32x2*)p = pack4(o0); *(u32x2*)(p + 32) = pack4(o1); }
                    else { *(v4u*)(Vb + (size_t)row * 128 + wc * 32 + 8 * fq) = pack8(v0, v1); } } } }
        } else if (pn < 10) {
#pragma unroll
            EPI_LOOP_ROWS { const int row = row0 + ai * 128 + m * 16; const float rs = rsv[ai][m];
#pragma unroll
                for (int bj = 0; bj < 2; ++bj) *(v4u*)(Zs + (size_t)row * NSHIFT + (pn - 3) * 256 + bj * 128 + wc * 32 + 8 * fq) = pack8(acc[ai][bj][m][0] * rs, acc[ai][bj][m][1] * rs); }
        } else {
#pragma unroll
            EPI_LOOP_ROWS { const int row = row0 + ai * 128 + m * 16; const float rs = rsv[ai][m];
                v4u w16;
#pragma unroll
                for (int bj = 0; bj < 2; ++bj) { const float nk = rs * -LOG2E; f32x4 g0, g1; u32x2 w;
#pragma unroll
                    for (int j = 0; j < 4; ++j) { g0[j] = __builtin_amdgcn_rcpf(__builtin_fmaf(__builtin_amdgcn_exp2f(acc[ai][bj][m][0][j] * nk), 1.0f / 255.0f, 1.0f / 255.0f));
                        g1[j] = __builtin_amdgcn_rcpf(__builtin_fmaf(__builtin_amdgcn_exp2f(acc[ai][bj][m][1][j] * nk), 1.0f / 255.0f, 1.0f / 255.0f)); }
                    w.x = __builtin_amdgcn_cvt_pk_u8_f32(g0[3], 3, __builtin_amdgcn_cvt_pk_u8_f32(g0[2], 2, __builtin_amdgcn_cvt_pk_u8_f32(g0[1], 1, __builtin_amdgcn_cvt_pk_u8_f32(g0[0], 0, 0u))));
                    w.y = __builtin_amdgcn_cvt_pk_u8_f32(g1[3], 3, __builtin_amdgcn_cvt_pk_u8_f32(g1[2], 2, __builtin_amdgcn_cvt_pk_u8_f32(g1[1], 1, __builtin_amdgcn_cvt_pk_u8_f32(g1[0], 0, 0u))));
                    w16[2 * bj] = w.x; w16[2 * bj + 1] = w.y; }
                *(v4u*)((unsigned char*)Gt + gate_blk(u.pm, pn - 10, ai, m, wr, wc) + (fr * 64 + fq * 16)) = w16; }
        }
    }
};

struct EpiLora {
    static constexpr bool PERM = true, AFTER_DRAIN = false; static constexpr int MIDK_T = 0;
    const float *w0, *a0, *k_a; bf16* DEC; bf16 *Kr, *KKb, *Bb, *Gg; int pn0;
    __device__ __forceinline__ void operator()(const f32x4 (&acc)[2][2][4][2], const pg8::Unit& u, int wr, int wc, int fr, int fq) const {
        const int pn = u.pn + pn0; const int row0 = u.pm * 256 + wr * 64 + fr;
#pragma unroll
        for (int bj = 0; bj < 2; ++bj) { int c = (pn & 1) * 256 + bj * 128 + wc * 32 + 8 * fq; asm volatile("" : "+v"(c));
            f32x4 bias[2];
#pragma unroll
            for (int n = 0; n < 2; ++n) bias[n] = (pn < 2) ? *(const f32x4*)(w0 + c + 4 * n) : (pn < 4) ? *(const f32x4*)(a0 + c + 4 * n) : (f32x4){0.f, 0.f, 0.f, 0.f};
#pragma unroll
            EPI_LOOP_ROWS { const int row = row0 + ai * 128 + m * 16;
                if (pn < 2) { f32x4 o[2];
#pragma unroll
                    for (int n = 0; n < 2; ++n) { const f32x4 v = acc[ai][bj][m][n] + bias[n];
#pragma unroll
                        for (int j = 0; j < 4; ++j) o[n][j] = (-0.6065306597126334f * LOG2E) * sigmoidf_(v[j]); }
                    *(v4u*)(DEC + (size_t)row * CW + c) = pack8(o[0], o[1]); }
                else if (pn < 4) { f32x4 av[2];
#pragma unroll
                    for (int n = 0; n < 2; ++n) av[n] = sig4(bias[n] + acc[ai][bj][m][n]);
                    *(v4u*)(Bb + (size_t)row * CW + c) = pack8(av[0], av[1]); }
                else { *(v4u*)(Gg + (size_t)row * CW + c) = pack8(acc[ai][bj][m][0], acc[ai][bj][m][1]); }
                asm volatile("" ::: "memory"); } }
    }
};
__device__ __forceinline__ f32x4 u8x4f(unsigned w) { return (f32x4){(float)(w & 0xffu), (float)((w >> 8) & 0xffu), (float)((w >> 16) & 0xffu), (float)(w >> 24)}; }
struct EpiMerge2 {
    static constexpr bool PERM = true, AFTER_DRAIN = false; static constexpr int MIDK_T = 8;
    const unsigned char* Gt; bf16* M;
    __device__ __forceinline__ void mid(f32x4 (&acc)[2][2][4][2], const pg8::Unit& u, int wr, int wc, int fr, int fq) const {
        int lo = fr * 64 + fq * 16; asm volatile("" : "+v"(lo));
        v4u ga[2][4], gb[2][4];
#pragma unroll
        EPI_LOOP_ROWS {
#pragma unroll
            for (int bj = 0; bj < 1; ++bj) { ga[ai][m] = __builtin_nontemporal_load((const v4u*)(Gt + gate_blk(u.pm, u.pn, ai, m, wr, wc) + lo)); gb[ai][m] = *(const v4u*)(Gt + gate_blk(u.pm, 4 + u.pn, ai, m, wr, wc) + lo); } }
#pragma unroll
        EPI_LOOP_ROWS {
#pragma unroll
            for (int bj = 0; bj < 2; ++bj) {
#pragma unroll
                for (int n = 0; n < 2; ++n) { const f32x4 a = u8x4f(ga[ai][m][2 * bj + n]), b = u8x4f(gb[ai][m][2 * bj + n]); f32x4 r;
#pragma unroll
                    for (int j = 0; j < 4; ++j) r[j] = a[j] * __builtin_amdgcn_rcpf(fmaxf(b[j], 1.0f));
                    acc[ai][bj][m][n] *= r; } } }
    }
    __device__ __forceinline__ void operator()(const f32x4 (&acc)[2][2][4][2], const pg8::Unit& u, int wr, int wc, int fr, int fq) const {
        const int row0 = u.pm * 256 + wr * 64 + fr;
        v4u gb[2][4];
#pragma unroll
        EPI_LOOP_ROWS gb[ai][m] = __builtin_nontemporal_load((const v4u*)(Gt + gate_blk(u.pm, 4 + u.pn, ai, m, wr, wc) + (fr * 64 + fq * 16)));
#pragma unroll
        EPI_LOOP_ROWS { const int row = row0 + ai * 128 + m * 16;
#pragma unroll
            for (int bj = 0; bj < 2; ++bj) { const int c = u.pn * 256 + bj * 128 + wc * 32 + 8 * fq;
                const f32x4 b0 = u8x4f(gb[ai][m][2 * bj]), b1 = u8x4f(gb[ai][m][2 * bj + 1]); f32x4 s0, s1;
#pragma unroll
                for (int j = 0; j < 4; ++j) { s0[j] = fmaxf(b0[j], 1.0f) * (1.0f / 255.0f); s1[j] = fmaxf(b1[j], 1.0f) * (1.0f / 255.0f); }
                *(v4u*)(M + (size_t)row * DM + c) = pack8(acc[ai][bj][m][0] * s0, acc[ai][bj][m][1] * s1); }
            asm volatile("" ::: "memory"); }
    }
};

struct EpiOut {
    static constexpr bool PERM = true, AFTER_DRAIN = false; static constexpr int MIDK_T = 0;
    bf16* X1b; float* ssq;
    __device__ __forceinline__ void operator()(const f32x4 (&acc)[2][2][4][2], const pg8::Unit& u, int wr, int wc, int fr, int fq) const {
        const int row0 = u.pm * 256 + wr * 64 + fr;
        bf16* xp = X1b + (size_t)row0 * DM + u.pn * 256 + wc * 32 + 8 * fq;
        v4u xw[2][4][2];
#pragma unroll
        EPI_LOOP_ROWS {
#pragma unroll
            for (int bj = 0; bj < 2; ++bj) xw[ai][m][bj] = __builtin_nontemporal_load((const v4u*)(xp + (size_t)(ai * 128 + m * 16) * DM + bj * 128)); }
#pragma unroll
        EPI_LOOP_ROWS { const int row = row0 + ai * 128 + m * 16; float s = 0.f;
#pragma unroll
            for (int bj = 0; bj < 2; ++bj) {
                const f32x4 o0 = unlo(xw[ai][m][bj]) + acc[ai][bj][m][0], o1 = unhi(xw[ai][m][bj]) + acc[ai][bj][m][1];
                *(v4u*)(xp + (size_t)(ai * 128 + m * 16) * DM + bj * 128) = pack8(o0, o1);
                s += ((o0[0] * o0[0] + o0[1] * o0[1]) + (o0[2] * o0[2] + o0[3] * o0[3])) + ((o1[0] * o1[0] + o1[1] * o1[1]) + (o1[2] * o1[2] + o1[3] * o1[3])); }
            s += __shfl_xor(s, 16); s += __shfl_xor(s, 32);
            if (fq == 0) ssq[(size_t)(u.pn * 4 + wc) * T + row] = s;        }
    }
};

struct EpiRouter {
    static constexpr bool PERM = true, AFTER_DRAIN = false; static constexpr int MIDK_T = 0;
    const float* ssq; const float *bg, *be; float* rstd2; float* LOG;
    __device__ __forceinline__ void operator()(const f32x4 (&acc)[2][2][4][2], const pg8::Unit& u, int wr, int wc, int fr, int fq) const {
        if (wc >= 2) return;
        const int row0 = u.pm * 256 + wr * 64 + fr;
        float sv[2][4];
#pragma unroll
        EPI_LOOP_ROWS { const int row = row0 + ai * 128 + m * 16; sv[ai][m] = (ssq[(size_t)(4 * fq) * T + row] + ssq[(size_t)(4 * fq + 1) * T + row]) + (ssq[(size_t)(4 * fq + 2) * T + row] + ssq[(size_t)(4 * fq + 3) * T + row]); }
#pragma unroll
        EPI_LOOP_ROWS { const int row = row0 + ai * 128 + m * 16;
            float s = sv[ai][m];
            s += __shfl_xor(s, 16); s += __shfl_xor(s, 32);
            const float rs = __builtin_amdgcn_rsqf(s * (1.0f / DM) + NORM_EPS);
            if (wc == 0 && fq == 0) rstd2[row] = rs;
#pragma unroll
            for (int n = 0; n < 2; ++n) { const int c0 = wc * 32 + 8 * fq + 4 * n; if (c0 >= 36) continue; f32x4 o;
#pragma unroll
                for (int j = 0; j < 4; ++j) { const int cc = c0 + j; o[j] = acc[ai][0][m][n][j] * rs + (cc < 4 ? bg[cc] : be[cc - 4]); }
                *(f32x4*)(LOG + (size_t)row * 64 + c0) = o; } }
    }
};

struct EpiGU {
    static constexpr bool PERM = true, AFTER_DRAIN = false; static constexpr int MIDK_T = 0;
    const float* rowscale; bf16* HID;
    __device__ __forceinline__ void operator()(const f32x4 (&acc)[2][2][4][2], const pg8::Unit& u, int wr, int wc, int fr, int fq) const {
        const int row0 = u.pm * 256 + wr * 64 + fr;
        float rsv[2][4];
#pragma unroll
        EPI_LOOP_ROWS rsv[ai][m] = rowscale[row0 + ai * 128 + m * 16];
#pragma unroll
        EPI_LOOP_ROWS { const int row = row0 + ai * 128 + m * 16; const float rs = rsv[ai][m]; f32x4 h[2];
#pragma unroll
            for (int n = 0; n < 2; ++n) { const f32x4 g = acc[ai][0][m][n] * rs, up = acc[ai][1][m][n] * rs;
#pragma unroll
                for (int j = 0; j < 4; ++j) h[n][j] = g[j] * sigmoidf_(g[j]) * up[j]; }
            *(v4u*)(HID + (size_t)row * DEXP + u.pn * 128 + wc * 32 + 8 * fq) = pack8(h[0], h[1]); }
    }
};

struct EpiProbe {
    static constexpr bool PERM = true, AFTER_DRAIN = false; static constexpr int MIDK_T = 0;
    float* O;
    __device__ __forceinline__ void operator()(const f32x4 (&acc)[2][2][4][2], const pg8::Unit& u, int wr, int wc, int fr, int fq) const {
        f32x4 s = (f32x4){0.f, 0.f, 0.f, 0.f};
#pragma unroll
        for (int ai = 0; ai < 2; ++ai)
#pragma unroll
            for (int bj = 0; bj < 2; ++bj)
#pragma unroll
                for (int m = 0; m < 4; ++m) s += acc[ai][bj][m][0] + acc[ai][bj][m][1];
        if (s[0] + s[1] + s[2] + s[3] == 12345.678f) O[u.pm + wr + wc + fr + fq] = s[0];
    }
};
struct EpiStore {
    static constexpr bool PERM = true, AFTER_DRAIN = false; static constexpr int MIDK_T = 0;
    bf16* O; int ldc;
    __device__ __forceinline__ void operator()(const f32x4 (&acc)[2][2][4][2], const pg8::Unit& u, int wr, int wc, int fr, int fq) const {
        const int row0 = u.pm * 256 + wr * 64 + fr;
#pragma unroll
        EPI_LOOP_ROWS { const int row = row0 + ai * 128 + m * 16;
#pragma unroll
            for (int bj = 0; bj < 2; ++bj) *(v4u*)(O + (size_t)row * ldc + u.pn * 256 + bj * 128 + wc * 32 + 8 * fq) = pack8(acc[ai][bj][m][0], acc[ai][bj][m][1]); }
    }
};

__device__ __forceinline__ size_t pp_blk(int pm, int pn, int ai, int bj, int m, int wr, int wc) { return ((size_t)((((((pm * 4 + pn) * 2 + ai) * 2 + bj) * 4 + m) * 2 + wr) * 4 + wc)) * 512; }
struct EpiStoreBlk {
    static constexpr bool PERM = true, AFTER_DRAIN = false; static constexpr int MIDK_T = 0;
    bf16* O;
    __device__ __forceinline__ void operator()(const f32x4 (&acc)[2][2][4][2], const pg8::Unit& u, int wr, int wc, int fr, int fq) const {
#pragma unroll
        EPI_LOOP_ROWS {
#pragma unroll
            for (int bj = 0; bj < 2; ++bj) *(v4u*)(O + pp_blk(u.pm, u.pn, ai, bj, m, wr, wc) + (fr * 32 + fq * 8)) = pack8(acc[ai][bj][m][0], acc[ai][bj][m][1]); }
    }
};
struct EpiPle {
    static constexpr bool PERM = true, AFTER_DRAIN = false; static constexpr int MIDK_T = 0;
    const float* rstd3; const bf16* X2b; const bf16* PP; bf16* X3b; float* ssq;
    __device__ __forceinline__ void operator()(const f32x4 (&acc)[2][2][4][2], const pg8::Unit& u, int wr, int wc, int fr, int fq) const {
        const int row0 = u.pm * 256 + wr * 64 + fr;
        const size_t off0 = (size_t)row0 * DM + u.pn * 256 + wc * 32 + 8 * fq;
#pragma unroll
        for (int ai = 0; ai < 2; ++ai) {
            v4u pw[4][2], xw[4][2]; float rsv[4];
#pragma unroll
            for (int m = 0; m < 4; ++m) { rsv[m] = rstd3[row0 + ai * 128 + m * 16];
#pragma unroll
                for (int bj = 0; bj < 2; ++bj) { const size_t o_ = off0 + (size_t)(ai * 128 + m * 16) * DM + bj * 128; pw[m][bj] = __builtin_nontemporal_load((const v4u*)(PP + pp_blk(u.pm, u.pn, ai, bj, m, wr, wc) + (fr * 32 + fq * 8))); xw[m][bj] = __builtin_nontemporal_load((const v4u*)(X2b + o_)); } }
#pragma unroll
            for (int m = 0; m < 4; ++m) { const int row = row0 + ai * 128 + m * 16; const float rs = rsv[m]; float s = 0.f;
#pragma unroll
                for (int bj = 0; bj < 2; ++bj) { f32x4 o[2];
#pragma unroll
                    for (int n = 0; n < 2; ++n) { const f32x4 pp = n ? unhi(pw[m][bj]) : unlo(pw[m][bj]), x2 = n ? unhi(xw[m][bj]) : unlo(xw[m][bj]), v = acc[ai][bj][m][n] * rs;
#pragma unroll
                        for (int j = 0; j < 4; ++j) o[n][j] = x2[j] + sigmoidf_(v[j]) * pp[j];
                        s += (o[n][0] * o[n][0] + o[n][1] * o[n][1]) + (o[n][2] * o[n][2] + o[n][3] * o[n][3]); }
                    *(v4u*)(X3b + off0 + (size_t)(ai * 128 + m * 16) * DM + bj * 128) = pack8(o[0], o[1]); }
                s += __shfl_xor(s, 16); s += __shfl_xor(s, 32);
                if (fq == 0) ssq[(size_t)(u.pn * 4 + wc) * T + row] = s;        }
            asm volatile("" ::: "memory"); }
    }
};

__device__ __forceinline__ int opaque_s(int v) { asm volatile("" : "+s"(v)); return v; }
struct PanelOrder {
    static constexpr bool GATHER = false; __device__ __forceinline__ const int* rowtok() const { return nullptr; }
    int pm, nN;
    __device__ __forceinline__ bool next(int i, pg8::Unit& u) const { if (i >= nN) return false; u.pm = opaque_s(pm); u.pn = i; u.pb = i; return true; }
    __device__ __forceinline__ void a_ready(const pg8::Unit&) const {}
    __device__ __forceinline__ void done(const pg8::Unit&) const {}
};
__device__ __forceinline__ void wg_handover() { asm volatile("s_waitcnt vmcnt(0)" ::: "memory"); __syncthreads(); __builtin_amdgcn_fence(__ATOMIC_ACQUIRE, "agent"); asm volatile("s_waitcnt vmcnt(0)" ::: "memory"); __syncthreads(); }

template <bool GTH> struct MoeOrderT {
    static constexpr bool GATHER = GTH; const int* rtok; __device__ __forceinline__ const int* rowtok() const { return rtok; }
    int nunits, G, c; const LAS int* tile_e;
    __device__ __forceinline__ bool next(int i, pg8::Unit& u) const {
        long L = (long)i * G + c;
        const int nfull = nunits / G;
        if (i == nfull && (G & 31) == 0) { const int per = G >> 3, xcd = c / per, j = c - xcd * per; const int qd = (j >> 2) * 8 + xcd;
            if (qd * 4 >= nunits - nfull * G) return false; L = (long)nfull * G + qd * 4 + (j & 3); }
        if (L >= nunits) return false;
        const int rt = (int)(L >> 2), pn = (int)(L & 3); u.pm = rt; u.pn = pn; u.pb = tile_e[rt] * 4 + pn; return true; }
    __device__ __forceinline__ void a_ready(const pg8::Unit&) const {}
    __device__ __forceinline__ void done(const pg8::Unit&) const {}
};

__device__ __forceinline__ void unpack8(const v4u w, float (&v)[8]) { v[0] = bflo(w.x); v[1] = bfhi(w.x); v[2] = bflo(w.y); v[3] = bfhi(w.y); v[4] = bflo(w.z); v[5] = bfhi(w.z); v[6] = bflo(w.w); v[7] = bfhi(w.w); }
__device__ __forceinline__ void store8(bf16* p, const float (&v)[8]) { v4u o; o.x = cvt_pk(v[0], v[1]); o.y = cvt_pk(v[2], v[3]); o.z = cvt_pk(v[4], v[5]); o.w = cvt_pk(v[6], v[7]); *(GAS v4u*)p = o; }
__device__ __forceinline__ void shift8v(const v4u cw, const v4u pw, const f32x4 m0, const f32x4 m1, float (&o)[8]) {
    float c[8], p[8]; unpack8(cw, c); unpack8(pw, p);
#pragma unroll
    for (int j = 0; j < 8; ++j) o[j] = c[j] + (p[j] - c[j]) * (j < 4 ? m0[j] : m1[j - 4]);
}
__device__ __forceinline__ void rp1_phase(Frame& F, int pm) {
    const int lane = fresh_tid() & 63, l3 = lane & 31, sub = lane >> 5;
    const bf16* Zs = WSP(bf16, WS_ZS); const float* mup = INF(5);
    const int col = 1536 + 8 * l3;
    const f32x4 m0 = *(const f32x4*)(mup + col), m1 = *(const f32x4*)(mup + col + 4);
    for (int t0 = 256 * pm + 8 * F.wave; t0 < 256 * pm + 256; t0 += 8 * NWAVES) {
        v4u cw[4], pw[4];
#pragma unroll
        for (int q = 0; q < 4; ++q) { const int t = t0 + 2 * q + sub; cw[q] = *(const GAS v4u*)(Zs + (size_t)t * NSHIFT + col);
            pw[q] = (v4u){0u, 0u, 0u, 0u}; if ((t & (SEQ - 1)) != 0) pw[q] = *(const GAS v4u*)(Zs + (size_t)(t - 1) * NSHIFT + col); }
#pragma unroll
        for (int q = 0; q < 4; ++q) { const int t = t0 + 2 * q + sub; float v[8];
            shift8v(cw[q], pw[q], m0, m1, v);
#pragma unroll
            for (int j = 0; j < 8; ++j) { const float sg = sigmoidf_(l3 < 8 ? 2.0f * v[j] : v[j]);
                v[j] = (l3 < 8) ? 2.0f * sg - 1.0f : (l3 >= 16 ? sg : v[j]); }
            store8(WSP(bf16, WS_LIN) + (size_t)t * 256 + 8 * l3, v); }
    }
}

__device__ __forceinline__ void attn_phase(Frame& F) {
    LAS unsigned char* L = F.lds + RING_OFF;
    const int tid = fresh_tid(), lane = tid & 63, wave = F.wave, r = lane & 31, h = lane >> 5;
    const float* sinks = INF(16);
    const bf16* Qb = WSP(bf16, WS_QB); const bf16* Kb = WSP(bf16, WS_KB); const bf16* Vb = WSP(bf16, WS_VB); bf16* Yatt = WSP(bf16, WS_Y2);
    constexpr int NUN = BATCH * 2 * 16;
#define ATT_KVLOAD(Uu) do { const int n_ = (Uu) & 15, kvh_ = ((Uu) >> 4) & 1, b_ = (Uu) >> 5; const int tb_ = b_ * SEQ + n_ * 128; \
        _Pragma("unroll") for (int i = 0; i < 4; ++i) { const int q = tid + 512 * i, row = q >> 3, c16 = q & 7; const int tok = tb_ - 128 + row; \
            kp[i] = (v4u){0u, 0u, 0u, 0u}; vp[i] = (v4u){0u, 0u, 0u, 0u}; \
            if (n_ > 0 || i >= 2) { kp[i] = *(const GAS v4u*)(Kb + (size_t)tok * 128 + kvh_ * 64 + c16 * 8); vp[i] = *(const GAS v4u*)(Vb + (size_t)tok * 128 + kvh_ * 64 + c16 * 8); } } } while (0)
#define ATT_KVWRITE do { _Pragma("unroll") for (int i = 0; i < 4; ++i) { const int q = tid + 512 * i, row = q >> 3, c16 = q & 7; \
            *(LAS v4u*)(Ksm + row * 128 + ((c16 ^ ((row >> 1) & 7)) << 4)) = kp[i]; \
            *(LAS v4u*)(Vsm + row * 128 + ((c16 ^ (((row >> 1) & 1) << 2)) << 4)) = vp[i]; } } while (0)
#define ATT_QLOAD(dst, Uu, qsv) do { const int n_ = (Uu) & 15, kvh_ = ((Uu) >> 4) & 1, b_ = (Uu) >> 5; const int q0_ = b_ * SEQ + n_ * 128 + (wave & 1) * 64 + 32 * (qsv), hq_ = kvh_ * 4 + (wave >> 1); \
        _Pragma("unroll") for (int j = 0; j < 4; ++j) dst[j] = __builtin_nontemporal_load((const GAS v4u*)(Qb + (size_t)(q0_ + 8 * j + (lane >> 3)) * CW + hq_ * 64 + 8 * (lane & 7))); } while (0)
    const int nun = (F.vcu < NUN) ? (NUN - F.vcu + F.G - 1) / F.G : 0;
    if (nun == 0) return;
#define ATT_UNIT(i) ((F.G == 256) ? ((((F.vcu >> 5) * 4 + 3 - (i)) << 5) | (F.vcu & 31)) : (F.vcu + F.G * (i)))
    int ui = 0; int U = ATT_UNIT(0);
    float sinkA = sinks[wave >> 1] * LOG2E, sinkB = sinks[4 + (wave >> 1)] * LOG2E;
    asm volatile("" : "+v"(sinkA), "+v"(sinkB));
    LAS unsigned char* Ksm = L; LAS unsigned char* Vsm = L + 32768;
    v4u kp[4], vp[4];
    ATT_KVLOAD(U);
    v4u qc[4], qn[4];
    ATT_QLOAD(qc, U, 0);
    ATT_KVWRITE;
    __syncthreads();
    v4u po[4]; int pq0 = 0, phq = 0;
#pragma unroll
    for (int i = 0; i < 4; ++i) po[i] = (v4u){0u, 0u, 0u, 0u};
    LAS unsigned char* Osm = L + 65536 + wave * 4608;
#pragma unroll 1
    for (int it = 0; ; ++it) {
        const int qs = it & 1;
        const int n = U & 15, kvh = (U >> 4) & 1, b = U >> 5; const int tb = b * SEQ + n * 128;
        if (qs == 0 && it > 0) { __syncthreads(); ATT_KVWRITE; __syncthreads(); }
        const bool last = (qs == 1) && (ui + 1 >= nun);
        const int hq = kvh * 4 + (wave >> 1); const float sink2 = kvh ? sinkB : sinkA;
        {
            const int qo = (wave & 1) * 64 + 32 * qs, q0 = tb + qo, ks0 = qo >> 5;
            bf16x8 qf[4];
#pragma unroll
            for (int j = 0; j < 4; ++j) *(LAS v4u*)(Osm + (8 * j + (lane >> 3)) * 144 + (lane & 7) * 16) = qc[j];
#pragma unroll
            for (int s = 0; s < 4; ++s) qf[s] = *(const LAS bf16x8*)(Osm + r * 144 + (2 * s + h) * 16);
            f32x16 st[5];
#pragma unroll
            for (int t5 = 0; t5 < 5; ++t5) { const int key = 32 * (ks0 + t5) + r; f32x16 a;
#pragma unroll
                for (int i = 0; i < 16; ++i) a[i] = 0.f;
#pragma unroll
                for (int s = 0; s < 4; ++s) { const bf16x8 kf = *(const LAS bf16x8*)(Ksm + key * 128 + (((2 * s + h) ^ ((key >> 1) & 7)) << 4));
                    a = __builtin_amdgcn_mfma_f32_32x32x16_bf16(kf, qf[s], a, 0, 0, 0); }
                st[t5] = a; }
            __builtin_amdgcn_sched_barrier(0);
            if (qs == 0) { if (ui + 1 < nun) { const int Un = ATT_UNIT(ui + 1); ATT_KVLOAD(Un); } }
            if (it > 0) {
#pragma unroll
                for (int j = 0; j < 4; ++j) *(v4u*)(Yatt + (size_t)(pq0 + 8 * j + (lane >> 3)) * DM + phq * 64 + 8 * (lane & 7)) = po[j]; }
            if (!last) { const int Ux = qs ? ATT_UNIT(ui + 1) : U; ATT_QLOAD(qn, Ux, qs ^ 1); }
            __builtin_amdgcn_sched_barrier(0);
            float mx = sink2;
#pragma unroll
            for (int t5 = 0; t5 < 5; ++t5) { const bool dead = (n == 0) && (ks0 + t5 < 4);
#pragma unroll
                for (int i = 0; i < 16; ++i) { const int krow = (i & 3) + 8 * (i >> 2) + 4 * h; bool vis = !dead;
                    if (t5 == 0) vis = vis && (krow >= r + 1); if (t5 == 4) vis = vis && (krow <= r);
                    const float v = vis ? st[t5][i] : -INFINITY; st[t5][i] = v; mx = fmaxf(mx, v); } }
            mx = fmaxf(mx, __shfl_xor(mx, 32));
            float l = 0.f;
#pragma unroll
            for (int t5 = 0; t5 < 5; ++t5)
#pragma unroll
                for (int i = 0; i < 16; ++i) { const float p = __builtin_amdgcn_exp2f(st[t5][i] - mx); st[t5][i] = p; l += p; }
            l += __shfl_xor(l, 32); l += __builtin_amdgcn_exp2f(sink2 - mx);
            f32x16 o[2];
#pragma unroll
            for (int i = 0; i < 16; ++i) { o[0][i] = 0.f; o[1][i] = 0.f; }
            const int li = lane & 15, qrow = li >> 2, p4 = li & 3;
#pragma unroll
            for (int t5 = 0; t5 < 5; ++t5)
#pragma unroll
                for (int s2 = 0; s2 < 2; ++s2) {
                    bf16x8 pf; { const unsigned w0 = cvt_pk(st[t5][8 * s2 + 0], st[t5][8 * s2 + 1]), w1 = cvt_pk(st[t5][8 * s2 + 2], st[t5][8 * s2 + 3]), w2 = cvt_pk(st[t5][8 * s2 + 4], st[t5][8 * s2 + 5]), w3 = cvt_pk(st[t5][8 * s2 + 6], st[t5][8 * s2 + 7]);
                        const v4u w = (v4u){w0, w1, w2, w3}; pf = __builtin_bit_cast(bf16x8, w); }
                    const int row0 = 32 * (ks0 + t5) + 16 * s2 + 4 * h + qrow;
#pragma unroll
                    for (int dt = 0; dt < 2; ++dt) { const int col = dt * 32 + 16 * ((lane >> 4) & 1) + 4 * p4;
                        const int off0 = row0 * 128 + ((((col >> 3) ^ (((row0 >> 1) & 1) << 2)) << 4) | (((col >> 2) & 1) << 3));
                        const s16x4 lo = __builtin_bit_cast(s16x4, __builtin_amdgcn_ds_read_tr16_b64_v4i16((LAS s16x4*)(Vsm + off0)));
                        const s16x4 hi = __builtin_bit_cast(s16x4, __builtin_amdgcn_ds_read_tr16_b64_v4i16((LAS s16x4*)(Vsm + off0 + 8 * 128)));
                        const bf16x8 vf = (bf16x8){lo[0], lo[1], lo[2], lo[3], hi[0], hi[1], hi[2], hi[3]};
                        o[dt] = __builtin_amdgcn_mfma_f32_32x32x16_bf16(vf, pf, o[dt], 0, 0, 0); } }
            const float inv = __builtin_amdgcn_rcpf(l);
#pragma unroll
            for (int dt = 0; dt < 2; ++dt)
#pragma unroll
                for (int g = 0; g < 4; ++g) *(LAS u32x2*)(Osm + r * 144 + (dt * 32 + 8 * g + 4 * h) * 2) = pack4((f32x4){o[dt][4 * g], o[dt][4 * g + 1], o[dt][4 * g + 2], o[dt][4 * g + 3]} * inv);
#pragma unroll
            for (int j = 0; j < 4; ++j) po[j] = *(const LAS v4u*)(Osm + (8 * j + (lane >> 3)) * 144 + (lane & 7) * 16);
            pq0 = q0; phq = hq;
        }
        if (last) break;
#pragma unroll
        for (int s = 0; s < 4; ++s) qc[s] = qn[s];
        if (qs == 1) { ++ui; U = ATT_UNIT(ui); }
    }
#pragma unroll
    for (int j = 0; j < 4; ++j) *(v4u*)(Yatt + (size_t)(pq0 + 8 * j + (lane >> 3)) * DM + phq * 64 + 8 * (lane & 7)) = po[j];
    __syncthreads();
#undef ATT_UNIT
#undef ATT_KVLOAD
#undef ATT_KVWRITE
#undef ATT_QLOAD
}

#define DPPRED2(a, b) asm("s_nop 1\n\tv_add_f32_dpp %0, %0, %0 quad_perm:[1,0,3,2] row_mask:0xf bank_mask:0xf bound_ctrl:1\n\tv_add_f32_dpp %1, %1, %1 quad_perm:[1,0,3,2] row_mask:0xf bank_mask:0xf bound_ctrl:1\n\t" \
      "s_nop 0\n\tv_add_f32_dpp %0, %0, %0 quad_perm:[2,3,0,1] row_mask:0xf bank_mask:0xf bound_ctrl:1\n\tv_add_f32_dpp %1, %1, %1 quad_perm:[2,3,0,1] row_mask:0xf bank_mask:0xf bound_ctrl:1\n\t" \
      "s_nop 0\n\tv_add_f32_dpp %0, %0, %0 row_half_mirror row_mask:0xf bank_mask:0xf bound_ctrl:1\n\tv_add_f32_dpp %1, %1, %1 row_half_mirror row_mask:0xf bank_mask:0xf bound_ctrl:1\n\t" \
      "s_nop 0\n\tv_add_f32_dpp %0, %0, %0 row_mirror row_mask:0xf bank_mask:0xf bound_ctrl:1\n\tv_add_f32_dpp %1, %1, %1 row_mirror row_mask:0xf bank_mask:0xf bound_ctrl:1" : "+v"(a), "+v"(b))
#ifndef SCSKIP
#define SCSKIP 0
#endif
constexpr int SC_CH = 32, SC_NCH = SEQ / SC_CH;
constexpr int SC_ST = 0;
constexpr int SC_STB = 32768;
constexpr int SC_G = 65536;
constexpr int SC_KT = 73728, SC_RT = SC_KT + 4096, SC_KD = SC_RT + 4096, SC_BD = SC_KD + 4096;
constexpr int SC_KH = SC_BD + 4096, SC_BH = SC_KH + 4096, SC_VV = SC_BH + 4096, SC_UU = SC_VV + 4096;
constexpr int SC_HI = SC_UU + 4096;
constexpr int SC_XAK = SC_HI + 8192, SC_XPK = SC_XAK + 2048, SC_XPB = SC_XPK + 2048;
constexpr int SC_AB = SC_XPB + 2048;
constexpr int SC_RHS = SC_KT;
constexpr int SC_BON = SC_AB + 2048, SC_GC = SC_BON + 256, SC_LNW = SC_GC + 256, SC_LNB = SC_LNW + 256, SC_END = SC_LNB + 256;
static_assert(SC_END <= RING_BYTES, "scan LDS map");
__device__ __forceinline__ int imgA(int row, int c16) { return row * 128 + ((c16 ^ ((row >> 1) & 7)) << 4); }
__device__ __forceinline__ int imgT(int row, int col) { return row * 128 + ((((col >> 3) ^ (((row >> 1) & 1) << 2)) << 4) | (((col >> 2) & 1) << 3)); }
__device__ __forceinline__ int imgX(int t, int c16) { return t * 64 + ((c16 ^ ((t >> 2) & 3)) << 4); }
__device__ __forceinline__ bf16x8 fragA(LAS unsigned char* img, int row, int s, int h) { return *(const LAS bf16x8*)(img + imgA(row, 2 * s + h)); }
__device__ __forceinline__ bf16x8 fragX(LAS unsigned char* img, int t, int s, int h) { return *(const LAS bf16x8*)(img + imgX(t, 2 * s + h)); }
__device__ __forceinline__ bf16x8 fragT(LAS unsigned char* img, int s, int colbase, int lane) {
    const int li = lane & 15, row0 = 16 * s + 8 * (lane >> 5) + (li >> 2), col = colbase + 16 * ((lane >> 4) & 1) + 4 * (li & 3);
    LAS unsigned char* p = img + imgT(row0, col);
    const s16x4 lo = __builtin_bit_cast(s16x4, __builtin_amdgcn_ds_read_tr16_b64_v4i16((LAS s16x4*)p));
    const s16x4 hi = __builtin_bit_cast(s16x4, __builtin_amdgcn_ds_read_tr16_b64_v4i16((LAS s16x4*)(p + 4 * 128)));
    return (bf16x8){lo[0], lo[1], lo[2], lo[3], hi[0], hi[1], hi[2], hi[3]};
}
constexpr int SC_U32 = SC_KD, SC_YB = RING_BYTES + 6144;
static_assert(SC_YB + 8192 <= LDS_BYTES, "scan YB");
constexpr int SC_TINV = SC_END;
constexpr int SC_TOT = SC_TINV + 1024;
constexpr int SC_CST = SC_TOT + 2048;
constexpr int SC_END2 = SC_CST + 2048;
static_assert(SC_END2 <= RING_BYTES, "scan LDS map (2)");
constexpr int SC_XPB1 = SC_TINV;
constexpr int SC_KH1 = SC_ST + 20480, SC_BH1 = SC_STB + 20480, SC_VV1 = RING_BYTES + 1024, SC_RHSI = SC_YB;
static_assert(SC_VV1 + 4096 <= SC_YB, "scan VV1");
template <bool CHECK, int SKIP = SCSKIP> __device__ __forceinline__ void scan_phase_t(Frame& F) {
    LAS unsigned char* L = F.lds + RING_OFF;
    const int tid = fresh_tid(), lane = tid & 63, wave = F.wave, kg = tid & 15, rg = tid >> 4, r32 = lane & 31, h = lane >> 5;
#define Zsb WSP(bf16, WS_ZS)
#define Bbb WSP(bf16, WS_BB)
#define DEC WSP(bf16, WS_DEC)
#define Gg WSP(bf16, WS_GG)
#define Yrw (WSP(bf16, WS_Y2) + CW)
    const float* lnwp = INF(14); const float* lnbp = INF(15); const float* rkp = INF(13); const float* kap = INF(12); const float* mup = INF(5); const float* kkp = INF(11);
    for (int U = F.vcu; U < BATCH * 8; U += F.G) {
        const int b = U >> 3, hh = U & 7, cb = hh * 64; const size_t tok0 = (size_t)b * SEQ;
        if (tid < 64) { LAS float* cst = (LAS float*)(L + SC_CST); cst[384 + tid] = lnwp[cb + tid]; cst[448 + tid] = lnbp[cb + tid]; cst[tid] = mup[cb + tid]; cst[64 + tid] = mup[512 + cb + tid]; cst[128 + tid] = mup[1024 + cb + tid]; cst[192 + tid] = kkp[cb + tid]; cst[256 + tid] = kap[cb + tid]; cst[320 + tid] = rkp[cb + tid]; }
        for (int i = tid; i < 8192 / 4; i += NWAVES * 64) ((LAS unsigned*)(L + SC_HI))[i] = 0u;
        f32x16 HT;
        f32x16 NP, NPT, NTT;
#pragma unroll
        for (int i = 0; i < 16; ++i) { HT[i] = 0.f; NP[i] = 0.f; NPT[i] = 0.f; NTT[i] = 0.f; }
        v4u pre[3]; u32x2 predraw, vcur = (u32x2){0u, 0u}, gcur = vcur, vprev = vcur, gprev = vcur;
#define SC_ISSUE(c) do { _Pragma("unroll") for (int i = 0; i < 3; ++i) { const int q = tid + 512 * i; const int a = q >> 8, rem = q & 255, tk = rem >> 3, c8 = rem & 7; if (a < 5) { \
            const size_t tk_ = tok0 + (size_t)(c) * SC_CH + tk; \
            const bf16* src = (a < 3) ? (Zsb + tk_ * NSHIFT + a * 512 + cb + 8 * c8) : ((a == 3 ? Bbb : Gg) + tk_ * CW + cb + 8 * c8); pre[i] = __builtin_nontemporal_load((const GAS v4u*)src); } } \
            predraw = __builtin_nontemporal_load((const GAS u32x2*)(DEC + (tok0 + (size_t)(c) * SC_CH + rg) * CW + cb + 4 * kg)); } while (0)
#define SC_WRITE(dst) do { _Pragma("unroll") for (int i = 0; i < 3; ++i) { const int q = tid + 512 * i; const int a = q >> 8, rem = q & 255, tk = rem >> 3, c8 = rem & 7; \
            if (a < 5) *(LAS v4u*)((dst) + a * 4096 + tk * 128 + c8 * 16) = pre[i]; } \
            *(LAS f32x4*)((dst) + 24576 + rg * 256 + kg * 16) = unpack4(predraw); } while (0)
#define SC_PREFIX(src, par) do { if (wave == 1 || wave == 2) { const int ch = (wave - 1) * 32 + r32; const LAS float* lam = (const LAS float*)((src) + 24576) + ch; LAS float* gout = (LAS float*)(Lc + SC_G) + ch; \
            float pa[16], run = 0.f; _Pragma("unroll") for (int j = 0; j < 16; ++j) { run += lam[(16 * h + j) * 64]; pa[j] = run; } \
            const float oth = __shfl_xor(run, 32), add = h ? oth : 0.f; \
            _Pragma("unroll") for (int j = 0; j < 16; ++j) gout[(16 * h + j) * 64] = pa[j] + add; \
            if (h) ((LAS float*)(Lc + SC_GC + 256 * (par)))[ch] = __builtin_amdgcn_exp2f(run + add); } } while (0)
#define SC_POST(cc, vv_, gg_) do { const size_t tok = tok0 + (size_t)(cc) * SC_CH + rg; \
              const f32x4 y = *(const LAS f32x4*)(Lc + SC_YB + rg * 256 + kg * 16); \
              float s = (y[0] + y[1]) + (y[2] + y[3]), q = (y[0] * y[0] + y[1] * y[1]) + (y[2] * y[2] + y[3] * y[3]); DPPRED2(s, q); \
              const float mean = s * (1.0f / 64.0f); const f32x4 dv = y - mean; \
              const float rs = __builtin_amdgcn_rsqf(fmaxf(q * (1.0f / 64.0f) - mean * mean, 0.f) + GN_EPS); \
              const f32x4 lnw = *(const LAS f32x4*)(Lc + SC_CST + 1536 + kg * 16), lnb = *(const LAS f32x4*)(Lc + SC_CST + 1792 + kg * 16); \
              const float bon = ((const LAS float*)(Lc + SC_BON + 128 * ((cc) & 1)))[rg]; \
              const f32x4 o = ((dv * rs) * lnw + lnb + unpack4(vv_) * bon) * unpack4(gg_); \
              if (CHECK) { const u32x2 nw = pack4(o), od = *(const u32x2*)(Yrw + tok * DM + cb + 4 * kg); if (nw.x != od.x || nw.y != od.y) WSP(unsigned, WS_CTL)[16] = 1u; } \
              else *(u32x2*)(Yrw + tok * DM + cb + 4 * kg) = pack4(o); } while (0)
#define ACCFRAG(X, s) __builtin_bit_cast(bf16x8, (v4u){cvt_pk(X[8 * (s)], X[8 * (s) + 1]), cvt_pk(X[8 * (s) + 2], X[8 * (s) + 3]), cvt_pk(X[8 * (s) + 4], X[8 * (s) + 5]), cvt_pk(X[8 * (s) + 6], X[8 * (s) + 7])})
#define ACCMM(D, W, X, C0) do { const bf16x8 w0_ = ACCFRAG(W, 0), w1_ = ACCFRAG(W, 1), x0_ = ACCFRAG(X, 0), x1_ = ACCFRAG(X, 1); \
            D = __builtin_amdgcn_mfma_f32_32x32x16_bf16(w0_, x0_, C0, 0, 0, 0); D = __builtin_amdgcn_mfma_f32_32x32x16_bf16(w1_, x1_, D, 0, 0, 0); } while (0)
#define NEU_STEP(last) do { f32x16 zero16_, q0_, q1_; _Pragma("unroll") for (int i = 0; i < 16; ++i) zero16_[i] = 0.f; \
            ACCMM(q0_, NPT, NP, zero16_); if (!(last)) { ACCMM(q1_, NP, NPT, zero16_); NPT = q1_; } NP = q0_; ACCMM(q1_, NP, NTT, NTT); NTT = q1_; } while (0)
        SC_ISSUE(0); SC_WRITE(L + SC_ST); SC_ISSUE(1);
        __syncthreads();
        { LAS unsigned char* Lc = L; asm volatile("" : "+v"(Lc)); SC_PREFIX(Lc + SC_ST, 0); }
        __syncthreads();
#pragma unroll 1
        for (int c = -1; c < SC_NCH; ++c) {
            LAS unsigned char* Lc = L; asm volatile("" : "+v"(Lc));
            const int p = c & 1;
            LAS unsigned char* stc = Lc + (p ? SC_STB : SC_ST); LAS unsigned char* stq = Lc + (p ? SC_ST : SC_STB);
            LAS unsigned char* ikh = Lc + (p ? SC_KH1 : SC_KH); LAS unsigned char* ibh = Lc + (p ? SC_BH1 : SC_BH); LAS unsigned char* ivv = Lc + (p ? SC_VV1 : SC_VV);
            f32x16 acc;
            if (c >= 0) {
                if (wave < 4 && !(SKIP & 8) && c > 0) { SC_POST(c - 1, vprev, gprev); }
                if (SKIP & 2) { if (wave >= 4) { _Pragma("unroll") for (int i = 0; i < 16; ++i) acc[i] = 0.f; } } else
                if (wave == 0) { if (!(SKIP & 32)) {
                    NEU_STEP(false); NEU_STEP(true); }
#pragma unroll
                    for (int g = 0; g < 4; ++g) *(LAS u32x2*)(Lc + SC_AB + imgX(r32, g) + 8 * h) = pack4((f32x4){NTT[4 * g], NTT[4 * g + 1], NTT[4 * g + 2], NTT[4 * g + 3]});
                } else if (wave >= 4) { const int vt = wave & 1; LAS unsigned char* ib = Lc + (wave < 6 ? SC_KT : SC_RT);
#pragma unroll
                    for (int i = 0; i < 16; ++i) acc[i] = 0.f;
#pragma unroll
                    for (int s = 0; s < 4; ++s) acc = __builtin_amdgcn_mfma_f32_32x32x16_bf16(fragT(Lc + SC_HI, s, vt * 32, lane), fragA(ib, r32, s, h), acc, 0, 0, 0);
                    LAS unsigned char* xi = Lc + (wave < 6 ? SC_XAK : SC_XPK);
#pragma unroll
                    for (int s = 0; s < 2; ++s) acc = __builtin_amdgcn_mfma_f32_32x32x16_bf16(fragT(ivv, s, vt * 32, lane), fragX(xi, r32, s, h), acc, 0, 0, 0);
                    if (wave < 6) {
#pragma unroll
                        for (int g = 0; g < 4; ++g) *(LAS u32x2*)(Lc + SC_UU + imgT(r32, vt * 32 + 8 * g + 4 * h)) = pack4((f32x4){acc[4 * g], acc[4 * g + 1], acc[4 * g + 2], acc[4 * g + 3]}); }
                }
                if (wave >= 4 && !(SKIP & 8) && c > 0) { SC_POST(c - 1, vprev, gprev); }
                if (c + 1 < SC_NCH) SC_PREFIX(stq, (c + 1) & 1);
                __syncthreads();
            }
            if (!(SKIP & 4) && c >= 0 && (wave == 4 || wave == 5)) { const int vt = wave & 1; f32x16 u;
#pragma unroll
                for (int i = 0; i < 16; ++i) u[i] = 0.f;
#pragma unroll
                for (int s = 0; s < 2; ++s) u = __builtin_amdgcn_mfma_f32_32x32x16_bf16(fragT(Lc + SC_UU, s, vt * 32, lane), fragX(Lc + SC_AB, r32, s, h), u, 0, 0, 0);
#pragma unroll
                for (int g = 0; g < 4; ++g) *(LAS u32x2*)(Lc + SC_UU + imgT(r32, vt * 32 + 8 * g + 4 * h)) = pack4((f32x4){u[4 * g], u[4 * g + 1], u[4 * g + 2], u[4 * g + 3]}); }
            if (!(SKIP & 1) && c + 1 < SC_NCH) {
              __builtin_amdgcn_sched_barrier(0);
              const int t = rg, c4 = 4 * kg;
              const f32x4 g = *(const LAS f32x4*)(Lc + SC_G + t * 256 + c4 * 4), gcv = *(const LAS f32x4*)(Lc + SC_GC + 256 * (1 - p) + c4 * 4);
              const f32x4 gp = g - *(const LAS f32x4*)(stq + 24576 + t * 256 + c4 * 4);
              const f32x4 mur = *(const LAS f32x4*)(Lc + SC_CST + c4 * 4), muk = *(const LAS f32x4*)(Lc + SC_CST + 256 + c4 * 4), muv = *(const LAS f32x4*)(Lc + SC_CST + 512 + c4 * 4);
              const f32x4 kkc = *(const LAS f32x4*)(Lc + SC_CST + 768 + c4 * 4), kac = *(const LAS f32x4*)(Lc + SC_CST + 1024 + c4 * 4), rkc = *(const LAS f32x4*)(Lc + SC_CST + 1280 + c4 * 4);
              const LAS unsigned char* pr = (t > 0) ? (stq + (t - 1) * 128) : (stc + 31 * 128); const bool hp = (t > 0 || c >= 0);
              const f32x4 r0 = unpack4(*(const LAS u32x2*)(stq + 0 * 4096 + t * 128 + c4 * 2)), k0 = unpack4(*(const LAS u32x2*)(stq + 1 * 4096 + t * 128 + c4 * 2)), v0 = unpack4(*(const LAS u32x2*)(stq + 2 * 4096 + t * 128 + c4 * 2));
              const f32x4 zero4 = (f32x4){0.f, 0.f, 0.f, 0.f};
              const f32x4 r1 = hp ? unpack4(*(const LAS u32x2*)(pr + 0 * 4096 + c4 * 2)) : zero4, k1 = hp ? unpack4(*(const LAS u32x2*)(pr + 1 * 4096 + c4 * 2)) : zero4, v1 = hp ? unpack4(*(const LAS u32x2*)(pr + 2 * 4096 + c4 * 2)) : zero4;
              const f32x4 rr = r0 + (r1 - r0) * mur, vsh = v0 + (v1 - v0) * muv; f32x4 kk = k0 + (k1 - k0) * muk;
              const f32x4 aa = unpack4(*(const LAS u32x2*)(stq + 3 * 4096 + t * 128 + c4 * 2));
              vprev = vcur; gprev = gcur; gcur = *(const LAS u32x2*)(stq + 4 * 4096 + t * 128 + c4 * 2);
              f32x4 ka = kk * kkc; float ss = (ka[0] * ka[0] + ka[1] * ka[1]) + (ka[2] * ka[2] + ka[3] * ka[3]);
              kk = kk * ((aa - 1.0f) * kac + 1.0f);
              float rk = (rr[0] * kk[0] * rkc[0] + rr[1] * kk[1] * rkc[1]) + (rr[2] * kk[2] * rkc[2] + rr[3] * kk[3] * rkc[3]);
              DPPRED2(ss, rk);
              ka = ka * fminf(__builtin_amdgcn_rsqf(ss), 1e12f);
              const f32x4 bb = ka * aa;
              vcur = pack4(vsh);
              f32x4 eg, egp, eng;
#pragma unroll
              for (int j = 0; j < 4; ++j) { eg[j] = __builtin_amdgcn_exp2f(g[j]); egp[j] = __builtin_amdgcn_exp2f(gp[j]); eng[j] = __builtin_amdgcn_rcpf(eg[j]); }
              const f32x4 egl = gcv * eng;
              const int oa = imgA(t, c4 >> 3) + (c4 & 7) * 2, ot = imgT(t, c4);
              *(LAS u32x2*)(Lc + SC_KT + oa) = pack4(ka * egp); *(LAS u32x2*)(Lc + SC_RT + oa) = pack4(rr * eg);
              *(LAS u32x2*)(Lc + SC_KD + oa) = pack4(kk * eng); *(LAS u32x2*)(Lc + SC_BD + oa) = pack4(bb * eng);
              *(LAS u32x2*)(Lc + (p ? SC_KH : SC_KH1) + ot) = pack4(kk * egl); *(LAS u32x2*)(Lc + (p ? SC_BH : SC_BH1) + ot) = pack4(bb * egl * -1.0f);
              *(LAS u32x2*)(Lc + (p ? SC_VV : SC_VV1) + ot) = vcur;
              if (kg == 0) ((LAS float*)(Lc + SC_BON + 128 * (1 - p)))[t] = rk;
            }
            __syncthreads();
            asm volatile("" : "=v"(NP), "=v"(NPT), "=v"(NTT));
            if (!(SKIP & 16) && c >= 0 && wave >= 4) { const int vt = wave & 1, kt = (wave >> 1) & 1;
                if (wave >= 6) {
#pragma unroll
                    for (int s = 0; s < 2; ++s) acc = __builtin_amdgcn_mfma_f32_32x32x16_bf16(fragT(Lc + SC_UU, s, vt * 32, lane), fragX(Lc + (p ? SC_XPB1 : SC_XPB), r32, s, h), acc, 0, 0, 0);
#pragma unroll
                    for (int g = 0; g < 4; ++g) *(LAS f32x4*)(Lc + SC_YB + r32 * 256 + (vt * 32 + 8 * g + 4 * h) * 4) = (f32x4){acc[4 * g], acc[4 * g + 1], acc[4 * g + 2], acc[4 * g + 3]}; }
                const float gc = ((const LAS float*)(Lc + SC_GC + 256 * p))[kt * 32 + r32];
#pragma unroll
                for (int i = 0; i < 16; ++i) HT[i] *= gc;
#pragma unroll
                for (int s = 0; s < 2; ++s) { HT = __builtin_amdgcn_mfma_f32_32x32x16_bf16(fragT(ivv, s, vt * 32, lane), fragT(ikh, s, kt * 32, lane), HT, 0, 0, 0);
                    HT = __builtin_amdgcn_mfma_f32_32x32x16_bf16(fragT(Lc + SC_UU, s, vt * 32, lane), fragT(ibh, s, kt * 32, lane), HT, 0, 0, 0); }
                const int k = kt * 32 + r32;
#pragma unroll
                for (int g = 0; g < 4; ++g) *(LAS u32x2*)(Lc + SC_HI + imgT(k, vt * 32 + 8 * g + 4 * h)) = pack4((f32x4){HT[4 * g], HT[4 * g + 1], HT[4 * g + 2], HT[4 * g + 3]});
            }
            if (!(SKIP & 32) && c + 1 < SC_NCH && wave == 0) {
                bf16x8 fk[4], fb[4];
#pragma unroll
                for (int s = 0; s < 4; ++s) { fk[s] = fragA(Lc + SC_KT, r32, s, h); fb[s] = fragA(Lc + SC_BD, r32, s, h); }
                f32x16 x, y;
#pragma unroll
                for (int i = 0; i < 16; ++i) { x[i] = 0.f; y[i] = 0.f; }
#pragma unroll
                for (int s = 0; s < 4; ++s) { x = __builtin_amdgcn_mfma_f32_32x32x16_bf16(fb[s], fk[s], x, 0, 0, 0); y = __builtin_amdgcn_mfma_f32_32x32x16_bf16(fk[s], fb[s], y, 0, 0, 0); }
                int tm = r32 - 4 * h; asm volatile("" : "+v"(tm));
#pragma unroll
                for (int i = 0; i < 16; ++i) { const int ci = (i & 3) + 8 * (i >> 2); NPT[i] = (ci < tm) ? x[i] : 0.f; NP[i] = (ci > tm) ? y[i] : 0.f; NTT[i] = ((ci == tm) ? 1.0f : 0.0f) - NPT[i]; }
                NEU_STEP(false); NEU_STEP(false);
            }
            if (!(SKIP & 2) && c + 1 < SC_NCH && wave >= 1 && wave < 4) {
                LAS unsigned char* ia = Lc + ((wave == 3) ? SC_BD : SC_KD); LAS unsigned char* ib = Lc + ((wave < 2) ? SC_KT : SC_RT);
                f32x16 x;
#pragma unroll
                for (int i = 0; i < 16; ++i) x[i] = 0.f;
#pragma unroll
                for (int s = 0; s < 4; ++s) x = __builtin_amdgcn_mfma_f32_32x32x16_bf16(fragA(ia, r32, s, h), fragA(ib, r32, s, h), x, 0, 0, 0);
                int tm = r32 - 4 * h; asm volatile("" : "+v"(tm));
#pragma unroll
                for (int i = 0; i < 16; ++i) { const int ci = (i & 3) + 8 * (i >> 2); const bool keep = (wave < 2) ? (ci < tm) : (ci <= tm); float v = keep ? x[i] : 0.f; if (wave == 3) v = -v; x[i] = v; }
                LAS unsigned char* xo = Lc + (wave == 1 ? SC_XAK : wave == 2 ? SC_XPK : (p ? SC_XPB : SC_XPB1));
#pragma unroll
                for (int g = 0; g < 4; ++g) *(LAS u32x2*)(xo + imgX(r32, g) + 8 * h) = pack4((f32x4){x[4 * g], x[4 * g + 1], x[4 * g + 2], x[4 * g + 3]});
            }
            if (!(SKIP & 64) && c + 2 < SC_NCH) { SC_WRITE(stc); if (c + 3 < SC_NCH) SC_ISSUE(c + 3); }
            __syncthreads();
        }
        { LAS unsigned char* Lc = L; asm volatile("" : "+v"(Lc)); SC_POST(SC_NCH - 1, vcur, gcur); }
        __syncthreads();
#undef NEU_STEP
#undef ACCMM
#undef ACCFRAG
#undef SC_POST
#undef Zsb
#undef Bbb
#undef DEC
#undef Gg
#undef Yrw
#undef SC_ISSUE
#undef SC_WRITE
#undef SC_PREFIX
    }
}

__device__ __forceinline__ void scan_phase(Frame& F) { scan_phase_t<false>(F); }

__device__ __forceinline__ void route_tile(Frame& F, int pm) {
    LAS unsigned* hist = (LAS unsigned*)(F.lds + RING_OFF);
    const int tid = fresh_tid();
    if (tid < 32) hist[tid] = 0u;
    __syncthreads();
    if (tid < 256) {
        const int t = pm * 256 + tid; const float* lg = WSP(float, WS_LOG) + (size_t)t * 64;
        const f32x4 g4 = *(const GAS f32x4*)lg;
        int gi = 0; float gm = g4[0];
        if (g4[1] > gm) { gm = g4[1]; gi = 1; } if (g4[2] > gm) { gm = g4[2]; gi = 2; } if (g4[3] > gm) { gm = g4[3]; gi = 3; }
        const float gden = (__expf(g4[0] - gm) + __expf(g4[1] - gm)) + (__expf(g4[2] - gm) + __expf(g4[3] - gm));
        const float gw = __builtin_amdgcn_rcpf(gden);
        const f32x4 e0 = *(const GAS f32x4*)(lg + 4 + gi * 8), e1 = *(const GAS f32x4*)(lg + 8 + gi * 8);
        float ev[8] = {e0[0], e0[1], e0[2], e0[3], e1[0], e1[1], e1[2], e1[3]};
        int i1 = 0; float m1 = ev[0];
#pragma unroll
        for (int j = 1; j < 8; ++j) if (ev[j] > m1) { m1 = ev[j]; i1 = j; }
        int i2 = -1; float m2 = -INFINITY;
#pragma unroll
        for (int j = 0; j < 8; ++j) if (j != i1 && ev[j] > m2) { m2 = ev[j]; i2 = j; }
        const float ex = __expf(m2 - m1); const float w1 = __builtin_amdgcn_rcpf(1.0f + ex), w2 = ex * w1;
        const int x1 = gi * 8 + i1, x2 = gi * 8 + i2;
        const unsigned r1 = __hip_atomic_fetch_add(hist + x1, 1u, __ATOMIC_RELAXED, __HIP_MEMORY_SCOPE_WORKGROUP);
        const unsigned r2 = __hip_atomic_fetch_add(hist + x2, 1u, __ATOMIC_RELAXED, __HIP_MEMORY_SCOPE_WORKGROUP);
        typedef int i32x2 __attribute__((ext_vector_type(2)));
        *(i32x2*)(WSP(int, WS_RT_E) + 2 * t) = (i32x2){x1, x2};
        *(f32x2*)(WSP(float, WS_RT_W) + 2 * t) = (f32x2){gw * w1, gw * w2};
        *(i32x2*)(WSP(int, WS_RT_RANK) + 2 * t) = (i32x2){(int)r1, (int)r2};
    }
    __syncthreads();
    if (tid < 32) WSP(int, WS_TABLE)[pm * 32 + tid] = (int)hist[tid];
    __syncthreads();
}

__device__ __forceinline__ void gather_phase(Frame& F) {
    LAS int* tab = (LAS int*)(F.lds + RING_OFF);
    LAS int* pstart = tab + 256 * 32;
    LAS int* base = pstart + 64;
    const int tid = fresh_tid(), lane = tid & 63, wave = F.wave;
    for (int i = tid; i < 256 * 32; i += NWAVES * 64) tab[i] = WSP(int, WS_TABLE)[i];
    __syncthreads();
    LAS int* psum = base + 64;
    { int s = 0; const int e_ = tid & 31, part = tid >> 5;
#pragma unroll
      for (int q = 0; q < 16; ++q) s += tab[(part * 16 + q) * 32 + e_];
      psum[part * 32 + e_] = s; }
    __syncthreads();
    if (tid < 32) { int s = 0;
#pragma unroll
      for (int q = 0; q < 16; ++q) s += psum[q * 32 + tid];
      base[tid] = (s + 255) & ~255; }
    __syncthreads();
    if (tid == 0) { int s = 0; for (int e = 0; e < NEXP; ++e) { pstart[e] = s; s += base[e]; } pstart[NEXP] = s; }
    __syncthreads();
    if (F.vcu == 0) {
        int* meta = WSP(int, WS_META); const int nrt = pstart[NEXP] >> 8;
        if (tid == 0) meta[0] = nrt;
        if (tid < 33) meta[1 + tid] = pstart[tid];
        for (int rt = tid; rt < nrt; rt += NWAVES * 64) { int e = 0;
            for (int j = 1; j < NEXP; ++j) if ((rt << 8) >= pstart[j]) e = j;
            meta[64 + rt] = e; }
    }
    for (int pm = F.vcu; pm < T / 256; pm += F.G) {
        __syncthreads();
        { int s = 0; const int e_ = tid & 31, part = tid >> 5;
#pragma unroll
          for (int q = 0; q < 16; ++q) { const int r_ = part * 16 + q; s += (r_ < pm) ? tab[r_ * 32 + e_] : 0; }
          psum[part * 32 + e_] = s; }
        __syncthreads();
        if (tid < 32) { int s = pstart[tid];
#pragma unroll
          for (int q = 0; q < 16; ++q) s += psum[q * 32 + tid];
          base[tid] = s; }
        __syncthreads();
        { const int t = pm * 256 + (tid >> 1), k = tid & 1; const int e = WSP(int, WS_RT_E)[2 * t + k], rk = WSP(int, WS_RT_RANK)[2 * t + k];
            const int pos = base[e] + rk; WSP(int, WS_RT_POS)[2 * t + k] = pos; WSP(float, WS_ROWSCALE)[pos] = WSP(float, WS_RSTD2)[t]; WSP(int, WS_ROWTOK)[pos] = t; }
    }
}

__device__ __forceinline__ void combine_phase(Frame& F, int pm) {
    const int lane = fresh_tid() & 63;
    constexpr int NT = 4;
    for (int t0 = 256 * pm + NT * F.wave; t0 < 256 * pm + 256; t0 += NT * NWAVES) {
        v4u a[NT][2], b0[NT][2], b1[NT][2]; float w0[NT], w1[NT];
#pragma unroll
        for (int q = 0; q < NT; ++q) { const int t = t0 + q; const int p0 = WSP(int, WS_RT_POS)[2 * t], p1 = WSP(int, WS_RT_POS)[2 * t + 1]; w0[q] = WSP(float, WS_RT_W)[2 * t]; w1[q] = WSP(float, WS_RT_W)[2 * t + 1];
            const GAS v4u* xb = (const GAS v4u*)(WSP(bf16, WS_XB) + (size_t)t * DM) + lane;
            const GAS v4u* y0 = (const GAS v4u*)(WSP(bf16, WS_Y) + (size_t)p0 * DM) + lane; const GAS v4u* y1 = (const GAS v4u*)(WSP(bf16, WS_Y) + (size_t)p1 * DM) + lane;
#pragma unroll
            for (int j = 0; j < 2; ++j) { a[q][j] = __builtin_nontemporal_load(xb + 64 * j); b0[q][j] = __builtin_nontemporal_load(y0 + 64 * j); b1[q][j] = __builtin_nontemporal_load(y1 + 64 * j); } }
        float s[NT];
#pragma unroll
        for (int q = 0; q < NT; ++q) { const int t = t0 + q; GAS v4u* xb = (GAS v4u*)(WSP(bf16, WS_XB) + (size_t)t * DM) + lane; s[q] = 0.f;
#pragma unroll
            for (int j = 0; j < 2; ++j) { v4u o;
#pragma unroll
                for (int i = 0; i < 4; ++i) { const unsigned aw = a[q][j][i], bw0 = b0[q][j][i], bw1 = b1[q][j][i];
                    const float lo = bflo(aw) + (bflo(bw0) * w0[q] + bflo(bw1) * w1[q]), hi = bfhi(aw) + (bfhi(bw0) * w0[q] + bfhi(bw1) * w1[q]);
                    s[q] += lo * lo + hi * hi; o[i] = cvt_pk(lo, hi); }
                xb[64 * j] = o; } }
#pragma unroll
        for (int o = 1; o < 64; o <<= 1) {
#pragma unroll
            for (int q = 0; q < NT; ++q) s[q] += __shfl_xor(s[q], o); }
        { float sv = s[0]; if (lane == 1) sv = s[1]; asm volatile("" : "+v"(sv)); if (lane == 2) sv = s[2]; asm volatile("" : "+v"(sv)); if (lane == 3) sv = s[3];
          if (lane < 4) WSP(float, WS_RSTD3)[t0 + lane] = 1.0f / sqrtf(sv * (1.0f / DM) + NORM_EPS); }
    }
}

__device__ __forceinline__ void final_phase(Frame& F, int pm) {
    const int lane = fresh_tid() & 63;
    const GAS f32x4* gn = (const GAS f32x4*)INF(31) + lane; f32x4 g[4];
#pragma unroll
    for (int j = 0; j < 4; ++j) g[j] = gn[64 * j];
    const float chkmul = (WSP(unsigned, WS_CTL)[16] != 0u) ? __builtin_nanf("") : 1.0f;
    constexpr int NT = 8;
    for (int t0 = 256 * pm + NT * F.wave; t0 < 256 * pm + 256; t0 += NT * NWAVES) {
        u32x2 v[NT][4]; float sp[NT];
#pragma unroll
        for (int q = 0; q < NT; ++q) { const GAS u32x2* x = (const GAS u32x2*)(WSP(bf16, WS_X3B) + (size_t)(t0 + q) * DM) + lane; sp[q] = WSP(float, WS_SSQ4)[(size_t)(lane & 15) * T + t0 + q];
#pragma unroll
            for (int j = 0; j < 4; ++j) v[q][j] = __builtin_nontemporal_load(x + 64 * j); }
#pragma unroll
        for (int q = 0; q < NT; ++q) { float s = sp[q]; s += __shfl_xor(s, 1); s += __shfl_xor(s, 2); s += __shfl_xor(s, 4); s += __shfl_xor(s, 8);
            const float rs = __builtin_amdgcn_rsqf(s * (1.0f / DM) + NORM_EPS) * chkmul;
            GAS f32x4* o = (GAS f32x4*)(F.out + (size_t)(t0 + q) * DM) + lane;
#pragma unroll
            for (int j = 0; j < 4; ++j) __builtin_nontemporal_store(unpack4(v[q][j]) * rs * g[j], o + 64 * j); }
    }
}
#define DPPRED2_SEQ(a, b) asm("s_nop 1\n\tv_add_f32_dpp %0, %0, %0 quad_perm:[1,0,3,2] row_mask:0xf bank_mask:0xf bound_ctrl:1\n\tv_add_f32_dpp %1, %1, %1 quad_perm:[1,0,3,2] row_mask:0xf bank_mask:0xf bound_ctrl:1\n\t" \
      "s_nop 0\n\tv_add_f32_dpp %0, %0, %0 quad_perm:[2,3,0,1] row_mask:0xf bank_mask:0xf bound_ctrl:1\n\tv_add_f32_dpp %1, %1, %1 quad_perm:[2,3,0,1] row_mask:0xf bank_mask:0xf bound_ctrl:1\n\t" \
      "s_nop 0\n\tv_add_f32_dpp %0, %0, %0 row_half_mirror row_mask:0xf bank_mask:0xf bound_ctrl:1\n\tv_add_f32_dpp %1, %1, %1 row_half_mirror row_mask:0xf bank_mask:0xf bound_ctrl:1\n\t" \
      "s_nop 0\n\tv_add_f32_dpp %0, %0, %0 row_mirror row_mask:0xf bank_mask:0xf bound_ctrl:1\n\tv_add_f32_dpp %1, %1, %1 row_mirror row_mask:0xf bank_mask:0xf bound_ctrl:1" : "+v"(a), "+v"(b))
constexpr int SQ_CH = 32, SQ_NCH = SEQ / SQ_CH, SQ_A = SQ_CH * 64;
struct ScanOps { f32x4 r4, k4, kk4, b4, w4; f32x2 v2; };
__device__ __forceinline__ void scan_load(ScanOps& o, const LAS float* cur, int t, int kg, int rg) {
    o.r4 = *(const LAS f32x4*)(cur + 0 * SQ_A + t * 64 + 4 * kg); o.k4 = *(const LAS f32x4*)(cur + 1 * SQ_A + t * 64 + 4 * kg);
    o.kk4 = *(const LAS f32x4*)(cur + 3 * SQ_A + t * 64 + 4 * kg); o.b4 = *(const LAS f32x4*)(cur + 4 * SQ_A + t * 64 + 4 * kg);
    o.w4 = *(const LAS f32x4*)(cur + 5 * SQ_A + t * 64 + 4 * kg); o.v2 = *(const LAS f32x2*)(cur + 2 * SQ_A + t * 64 + 2 * rg);
}
__device__ __forceinline__ float mul_s(float a, float b) { float r; asm("v_mul_f32_e32 %0, %1, %2" : "=v"(r) : "v"(a), "v"(b)); return r; }
__device__ __forceinline__ float fmac_s(float acc, float a, float b) { asm("v_fmac_f32_e32 %0, %1, %2" : "+v"(acc) : "v"(a), "v"(b)); return acc; }
__device__ __forceinline__ void scan_step(float (&S0)[4], float (&S1)[4], const ScanOps& o, LAS float* yout) {
    float d0 = mul_s(S0[0], o.kk4[0]), d1 = mul_s(S1[0], o.kk4[0]);
    d0 = fmac_s(d0, S0[1], o.kk4[1]); d1 = fmac_s(d1, S1[1], o.kk4[1]);
    d0 = fmac_s(d0, S0[2], o.kk4[2]); d1 = fmac_s(d1, S1[2], o.kk4[2]);
    d0 = fmac_s(d0, S0[3], o.kk4[3]); d1 = fmac_s(d1, S1[3], o.kk4[3]);
    DPPRED2_SEQ(d0, d1);
#pragma unroll
    for (int i = 0; i < 4; ++i) {
        float t0 = mul_s(o.v2[0], o.k4[i]), t1 = mul_s(o.v2[1], o.k4[i]);
        t0 = fmac_s(t0, d0, o.b4[i]); t1 = fmac_s(t1, d1, o.b4[i]);
        S0[i] = fmac_s(t0, S0[i], o.w4[i]); S1[i] = fmac_s(t1, S1[i], o.w4[i]); }
    float y0 = mul_s(S0[0], o.r4[0]), y1 = mul_s(S1[0], o.r4[0]);
    y0 = fmac_s(y0, S0[1], o.r4[1]); y1 = fmac_s(y1, S1[1], o.r4[1]);
    y0 = fmac_s(y0, S0[2], o.r4[2]); y1 = fmac_s(y1, S1[2], o.r4[2]);
    y0 = fmac_s(y0, S0[3], o.r4[3]); y1 = fmac_s(y1, S1[3], o.r4[3]);
    DPPRED2_SEQ(y0, y1);
    *(LAS f32x2*)yout = (f32x2){y0, y1};
}
__device__ __forceinline__ float red16f(float x) { float z = 0.f; DPPRED2_SEQ(x, z); return x; }
__device__ __forceinline__ void scan_phase_seq(Frame& F) {
    LAS float* buf0 = (LAS float*)(F.lds + RING_OFF); LAS float* buf1 = buf0 + 6 * SQ_A; LAS float* ybuf = buf1 + 6 * SQ_A;
    const int tid = fresh_tid(), kg = tid & 15, rg = tid >> 4;
    const bf16* Rb = WSP(bf16, WS_R); const bf16* Krb = WSP(bf16, WS_KR); const bf16* Vrb = WSP(bf16, WS_VR); const bf16* KKb = WSP(bf16, WS_KK); const bf16* Bbb = WSP(bf16, WS_BB);
    const float* DEC = WSP(float, WS_DEC); const bf16* Gg = WSP(bf16, WS_GG); bf16* Yrw = WSP(bf16, WS_Y2);
    for (int U = F.vcu; U < BATCH * 8; U += F.G) {
        const int b = U >> 3, hh = U & 7, cb = hh * 64; const size_t tok0 = (size_t)b * SEQ;
        float S0[4] = {0.f, 0.f, 0.f, 0.f}, S1[4] = {0.f, 0.f, 0.f, 0.f};
        const f32x4 lnw = *(const f32x4*)(INF(14) + cb + 4 * kg), lnb = *(const f32x4*)(INF(15) + cb + 4 * kg), rkc = *(const f32x4*)(INF(13) + cb + 4 * kg);
        v4u pre[3]; f32x4 pred; u32x2 ggn, ggc;
#define SQ_ISSUE(c) do { _Pragma("unroll") for (int i = 0; i < 3; ++i) { const int q = tid + 512 * i; if (q < 1280) { const int a = q >> 8, rem = q & 255, tk = rem >> 3, c8 = rem & 7; \
            const bf16* src = (a == 0 ? Rb : a == 1 ? Krb : a == 2 ? Vrb : a == 3 ? KKb : Bbb) + (tok0 + (size_t)(c) * SQ_CH + tk) * CW + cb + 8 * c8; pre[i] = *(const GAS v4u*)src; } } \
            pred = *(const GAS f32x4*)(DEC + (tok0 + (size_t)(c) * SQ_CH + rg) * CW + cb + 4 * kg); \
            ggn = *(const GAS u32x2*)(Gg + (tok0 + (size_t)(c) * SQ_CH + rg) * CW + cb + 4 * kg); } while (0)
#define SQ_WRITE(dst) do { _Pragma("unroll") for (int i = 0; i < 3; ++i) { const int q = tid + 512 * i; if (q < 1280) { const int a = q >> 8, rem = q & 255, tk = rem >> 3, c8 = rem & 7; \
            LAS float* d = (dst) + a * SQ_A + tk * 64 + 8 * c8; const v4u w = pre[i]; \
            const float sg = (a == 4) ? -1.0f : 1.0f;   \
            *(LAS f32x4*)d = (f32x4){bflo(w.x), bfhi(w.x), bflo(w.y), bfhi(w.y)} * sg; *(LAS f32x4*)(d + 4) = (f32x4){bflo(w.z), bfhi(w.z), bflo(w.w), bfhi(w.w)} * sg; } } \
            *(LAS f32x4*)((dst) + 5 * SQ_A + rg * 64 + 4 * kg) = (f32x4){__expf(pred[0]), __expf(pred[1]), __expf(pred[2]), __expf(pred[3])}; } while (0)
        LAS float* const ywr = (kg == 0) ? (ybuf + 2 * rg) : (ybuf + SQ_A + 2 * tid); const int ystep = (kg == 0) ? 64 : 0;
        SQ_ISSUE(0); SQ_WRITE(buf0); ggc = ggn;
        __syncthreads();
#pragma unroll 1
        for (int c = 0; c < SQ_NCH; ++c) {
            LAS float* cur = (c & 1) ? buf1 : buf0; LAS float* nxt = (c & 1) ? buf0 : buf1;
            if (c + 1 < SQ_NCH) SQ_ISSUE(c + 1);
            ScanOps oa, ob; scan_load(oa, cur, 0, kg, rg);
#pragma unroll 1
            for (int t = 0; t < SQ_CH; t += 2) {
                scan_load(ob, cur, t + 1, kg, rg);
                scan_step(S0, S1, oa, ywr + t * ystep);
                scan_load(oa, cur, (t + 2) & (SQ_CH - 1), kg, rg);
                scan_step(S0, S1, ob, ywr + (t + 1) * ystep);
            }
            __syncthreads();
            { const int t = rg; const size_t tok = tok0 + (size_t)c * SQ_CH + t;
              const f32x4 y = *(const LAS f32x4*)(ybuf + t * 64 + 4 * kg);
              const f32x4 r4 = *(const LAS f32x4*)(cur + 0 * SQ_A + t * 64 + 4 * kg), k4 = *(const LAS f32x4*)(cur + 1 * SQ_A + t * 64 + 4 * kg), v4 = *(const LAS f32x4*)(cur + 2 * SQ_A + t * 64 + 4 * kg);
              float s = (y[0] + y[1]) + (y[2] + y[3]); float rk = (r4[0] * k4[0] * rkc[0] + r4[1] * k4[1] * rkc[1]) + (r4[2] * k4[2] * rkc[2] + r4[3] * k4[3] * rkc[3]);
              DPPRED2_SEQ(s, rk);
              const float mean = s * (1.0f / 64.0f); const f32x4 dv = y - mean; float q = (dv[0] * dv[0] + dv[1] * dv[1]) + (dv[2] * dv[2] + dv[3] * dv[3]);
              q = red16f(q);
              const float rs = 1.0f / sqrtf(q * (1.0f / 64.0f) + GN_EPS); const f32x4 g = unpack4(ggc);
              const f32x4 o = ((dv * rs) * lnw + lnb + v4 * rk) * g;
              *(u32x2*)(Yrw + tok * CW + cb + 4 * kg) = pack4(o); }
            if (c + 1 < SQ_NCH) { SQ_WRITE(nxt); ggc = ggn; }
            __syncthreads();
        }
#undef SQ_ISSUE
#undef SQ_WRITE
    }
}


#ifndef PG_ALIGN
#define PG_ALIGN true
#endif
#ifndef PG_SP2
#define PG_SP2 true
#endif
constexpr int NPH = 14;
struct Args { const void* in[32]; float* out; unsigned char* ws; int ph_lo, ph_hi; };
__global__ void __launch_bounds__(NWAVES * 64, 2) fwd_kernel(Args args) {
    extern __shared__ __attribute__((aligned(16))) unsigned char lds[];
    Frame F;
    F.lds = (LAS unsigned char*)lds;
    F.MISC = (volatile LAS unsigned*)(F.lds + MISC_OFF);
    F.wave = __builtin_amdgcn_readfirstlane((int)threadIdx.x >> 6);
    F.G = gridDim.x; { const int bx = blockIdx.x; F.vcu = (F.G % 8 == 0) ? (bx % 8) * (F.G / 8) + bx / 8 : bx; }
    F.ws = args.ws; F.out = args.out;
    F.ctl = (gu32*)(args.ws + WS_CTL);
    for (int u = fresh_tid(); u < (LDS_BYTES - LDSCTL_OFF) / 4; u += NWAVES * 64) ((LAS unsigned*)(F.lds + LDSCTL_OFF))[u] = 0u;
    __syncthreads();
    { const int t = fresh_tid(); if (t < 32) *(LAS unsigned long long*)(F.lds + INTAB_OFF + 8 * t) = (unsigned long long)args.in[t]; }
    __syncthreads();
#if MK_SINGLE
    XcdBarrier bar = xcd_barrier_post((unsigned*)(F.ctl + CW_BAR), F.MISC + 8);
#define GRID_BAR() xcd_barrier(bar)
#else
#define GRID_BAR() do { } while (0)
#endif
    const int lo = args.ph_lo, hi = args.ph_hi;
#ifndef PHMASK
#define PHMASK 0xFFFF
#endif
#define IN(k) (((PHMASK >> (k)) & 1) && lo <= (k) && (k) < hi)
#ifndef DBLMASK
#define DBLMASK 0
#endif
#define REP(k) _Pragma("unroll 1") for (int rep_ = 0; rep_ <= ((DBLMASK >> (k)) & 1); ++rep_)
#define SEAM(k) do { if (IN(k) && IN((k) + 1)) GRID_BAR(); } while (0)
    LAS unsigned char* ring = F.lds + RING_OFF;
    const int bx = (int)blockIdx.x;

    if (IN(0)) REP(0) { p0_prologue(F); } SEAM(0);
#ifdef XBAR
    for (int xb_ = 0; xb_ < XBAR; ++xb_) GRID_BAR();
#endif

    if (IN(1)) REP(1) {
#ifdef PROBE_BAR
        if (rep_ > 0) GRID_BAR();
#endif
        pg8::Gemm g{WSP(bf16, WS_XB), WSP(bf16, WS_WIN), T, NIN, DM}; pg8::StaticOrder S; S.init(T, NIN, F.G, bx);
        EpiZ E{WSP(float, WS_RSTD1), WSP(float, WS_ROPE), WSP(bf16, WS_QB), WSP(bf16, WS_KB), WSP(bf16, WS_VB), WSP(bf16, WS_ZS), (bf16*)F.out};
        pg8::gemm_phase<EpiZ, pg8::StaticOrder, PG_ALIGN, PG_SP2>(ring, g, S, E, F.wave);
    } SEAM(1);

    if (IN(2)) {
        REP(3) attn_phase(F);
        REP(2) { for (int pm = F.vcu; pm < T / 256; pm += F.G) rp1_phase(F, pm); } } SEAM(2);

    if (IN(3)) {
        { pg8::Gemm g{WSP(bf16, WS_LIN), WSP(bf16, WS_WL), T, 1024, 128, 256}; pg8::StaticOrder S; S.init(T, 1024, F.G, bx);
          EpiLora E{INF(6), INF(8), INF(12), WSP(bf16, WS_DEC), WSP(bf16, WS_KR), WSP(bf16, WS_KK), WSP(bf16, WS_BB), WSP(bf16, WS_GG), 0};
          pg8::gemm_phase<EpiLora, pg8::StaticOrder, PG_ALIGN, PG_SP2>(ring, g, S, E, F.wave); }
        { pg8::Gemm g{WSP(bf16, WS_LIN) + 128, WSP(bf16, WS_WL) + (size_t)1024 * 256 + 128, T, 512, 128, 256}; pg8::StaticOrder S; S.init(T, 512, F.G, bx);
          EpiLora E{INF(6), INF(8), INF(12), WSP(bf16, WS_DEC), WSP(bf16, WS_KR), WSP(bf16, WS_KK), WSP(bf16, WS_BB), WSP(bf16, WS_GG), 4};
          pg8::gemm_phase<EpiLora, pg8::StaticOrder, PG_ALIGN, PG_SP2>(ring, g, S, E, F.wave); }
    } SEAM(3);

    #ifndef SCAN_MODE
#define SCAN_MODE 0
#endif
    if (IN(4)) REP(4) {
#ifdef SCAN_PROBE_SKIP
        scan_phase_t<false, SCAN_PROBE_SKIP>(F); __syncthreads();
#endif
#if SCAN_MODE != 2
        scan_phase(F);
#endif
#if SCAN_MODE == 3
        __syncthreads(); scan_phase_t<true>(F);
#endif
#if SCAN_MODE == 1 || SCAN_MODE == 2
        __syncthreads(); scan_phase_seq(F);
#endif
    } SEAM(4);

    if (IN(5)) REP(5) {
        pg8::Gemm g{WSP(bf16, WS_Y2), WSP(bf16, WS_WBA), T, DM, DM}; pg8::StaticOrder S; S.init(T, DM, F.G, bx);
        EpiMerge2 E{(const unsigned char*)F.out, WSP(bf16, WS_MRG)}; pg8::gemm_phase<EpiMerge2, pg8::StaticOrder, PG_ALIGN, PG_SP2>(ring, g, S, E, F.wave);
    } SEAM(5);

    if (IN(6)) REP(6) {
        pg8::Gemm g{WSP(bf16, WS_MRG), WSP(bf16, WS_WOUT), T, DM, DM}; pg8::StaticOrder S; S.init(T, DM, F.G, bx);
#ifdef PROBE_EPI6
        if (rep_ == 0) { EpiProbe EP{WSP(float, WS_LOG)}; pg8::gemm_phase<EpiProbe, pg8::StaticOrder, PG_ALIGN, PG_SP2>(ring, g, S, EP, F.wave); __syncthreads(); continue; }
#endif
        EpiOut E{WSP(bf16, WS_XB), WSP(float, WS_SSQ2)};
        pg8::gemm_phase<EpiOut, pg8::StaticOrder, PG_ALIGN, PG_SP2>(ring, g, S, E, F.wave);
    } SEAM(6);

    if (IN(7)) REP(7) {
        pg8::Gemm g{WSP(bf16, WS_XB), WSP(bf16, WS_WR), T, 256, DM}; pg8::StaticOrder S; S.init(T, 256, F.G, bx);
        EpiRouter E{WSP(float, WS_SSQ2), INF(22), INF(24), WSP(float, WS_RSTD2), WSP(float, WS_LOG)};
        pg8::gemm_phase<EpiRouter, pg8::StaticOrder, PG_ALIGN, PG_SP2>(ring, g, S, E, F.wave);
        __syncthreads();
        pg8::Unit u; for (int i = 0; S.next(i, u); ++i) route_tile(F, u.pm);
        for (int i = F.vcu * (NWAVES * 64) + fresh_tid(); i < PMAX; i += F.G * NWAVES * 64) WSP(int, WS_ROWTOK)[i] = 0;
    } SEAM(7);

    if (IN(8)) REP(8) { gather_phase(F); } SEAM(8);

    if (IN(9)) REP(9) {
        const int nrt = WSP(int, WS_META)[0]; LAS int* te = (LAS int*)(F.lds + TILEE_OFF);
        for (int i = fresh_tid(); i < nrt; i += NWAVES * 64) te[i] = WSP(int, WS_META)[64 + i];
        __syncthreads();
        pg8::Gemm g{WSP(bf16, WS_XB), WSP(bf16, WS_WGU), 0, 0, DM}; MoeOrderT<true> S{WSP(int, WS_ROWTOK), nrt * 4, F.G, F.vcu, te};
        EpiGU E{WSP(float, WS_ROWSCALE), WSP(bf16, WS_HID)};
        pg8::gemm_phase<EpiGU, MoeOrderT<true>, PG_ALIGN, PG_SP2>(ring, g, S, E, F.wave);
    } SEAM(9);

    if (IN(10)) REP(10) {
        const int nrt = WSP(int, WS_META)[0]; LAS int* te = (LAS int*)(F.lds + TILEE_OFF);
        for (int i = fresh_tid(); i < nrt; i += NWAVES * 64) te[i] = WSP(int, WS_META)[64 + i];
        __syncthreads();
        pg8::Gemm g{WSP(bf16, WS_HID), WSP(bf16, WS_WD), 0, 0, DEXP}; MoeOrderT<false> S{nullptr, nrt * 4, F.G, F.vcu, te};
        EpiStore E{WSP(bf16, WS_Y), DM};
        pg8::gemm_phase<EpiStore, MoeOrderT<false>, PG_ALIGN, PG_SP2>(ring, g, S, E, F.wave);
    } SEAM(10);

    if (IN(11)) { for (int pm = F.vcu; pm < T / 256; pm += F.G) combine_phase(F, pm); } SEAM(11);

    if (IN(12)) REP(12) {
        { pg8::Gemm g{WSP(bf16, WS_PB), WSP(bf16, WS_WPP), T, DM, PLE}; pg8::StaticOrder S; S.init(T, DM, F.G, bx);
          EpiStoreBlk E{WSP(bf16, WS_PP)}; pg8::gemm_phase<EpiStoreBlk, pg8::StaticOrder, PG_ALIGN, PG_SP2>(ring, g, S, E, F.wave); }
        { pg8::Gemm g{WSP(bf16, WS_XB), WSP(bf16, WS_WPG), T, DM, DM}; pg8::StaticOrder S; S.init(T, DM, F.G, bx);
          EpiPle E{WSP(float, WS_RSTD3), WSP(bf16, WS_XB), WSP(bf16, WS_PP), WSP(bf16, WS_X3B), WSP(float, WS_SSQ4)};
          pg8::gemm_phase<EpiPle, pg8::StaticOrder, PG_ALIGN, PG_SP2>(ring, g, S, E, F.wave); }
    } SEAM(12);

    if (IN(13)) { for (int pm = F.vcu; pm < T / 256; pm += F.G) final_phase(F, pm); }
#undef IN
#undef SEAM
}

extern "C" void kernel_launch(void* const* d_in, const int* in_sizes, int n_in, void* d_out, int out_size, void* d_ws, size_t ws_size, hipStream_t stream) {
    static int grid = 0;
    if (grid == 0) {
        if (n_in != 32 || in_sizes[0] != T * DM || out_size != T * DM || ws_size < WS_END) {
            fprintf(stderr, "kernel_launch: unexpected shapes (n_in %d, in0 %d, out %d, ws %zu); nothing launched\n", n_in, n_in > 0 ? in_sizes[0] : -1, out_size, ws_size); grid = -1; return; }
        int dev = 0, cus = 0, per_cu = 0;
        if (hipGetDevice(&dev) != hipSuccess || hipDeviceGetAttribute(&cus, hipDeviceAttributeMultiprocessorCount, dev) != hipSuccess) { grid = -1; return; }
        if (hipFuncSetAttribute((const void*)fwd_kernel, hipFuncAttributeMaxDynamicSharedMemorySize, LDS_BYTES) != hipSuccess) { fprintf(stderr, "kernel_launch: hipFuncSetAttribute failed\n"); grid = -1; return; }
        if (hipOccupancyMaxActiveBlocksPerMultiprocessor(&per_cu, (const void*)fwd_kernel, NWAVES * 64, LDS_BYTES) != hipSuccess || per_cu < 1) { fprintf(stderr, "kernel_launch: occupancy query says %d blocks per CU\n", per_cu); per_cu = 1; }
        (void)hipGetLastError();
        grid = cus;
    }
    if (grid < 0) return;
    Args a{};
    for (int i = 0; i < 32; ++i) a.in[i] = d_in[i];
    a.out = (float*)d_out; a.ws = (unsigned char*)d_ws;
#if MK_SINGLE
    (void)hipMemsetAsync((char*)d_ws + WS_CTL, 0, CTL_ZERO_BYTES, stream);
    a.ph_lo = 0; a.ph_hi = NPH;
    void* kargs[] = {&a};
    hipError_t e = hipLaunchCooperativeKernel((const void*)fwd_kernel, dim3(grid), dim3(NWAVES * 64), kargs, LDS_BYTES, stream);
    if (e != hipSuccess) fprintf(stderr, "kernel_launch: cooperative launch failed: %s (grid %d)\n", hipGetErrorString(e), grid);
#else
    for (int ph = 0; ph < NPH; ++ph) {
        a.ph_lo = ph; a.ph_hi = ph + 1;
        hipLaunchKernelGGL(fwd_kernel, dim3(grid), dim3(NWAVES * 64), LDS_BYTES, stream, a);
    }
#endif
}
```
